# Optimizing an MI355X kernel written in HIP

```python
import math
import jax, jax.numpy as jnp
from jax import lax
import numpy as np


D_MODEL = 1024
BATCH = 4
SEQ = 4096
DEPTH = 2
DEC_BATCH = 128
DEC_SEQ = 4
PAST_LEN = 2048
PAGE_SIZE = 128

MIX = D_MODEL
MIX_A = MIX // 2
H_A = 4
DA = MIX_A // (2 * H_A)
DV_A = 2 * DA
MIX_B = MIX - MIX_A
H_B = 4
DB = MIX_B // H_B
HI = 8
DI = 64
TOPK_MAX = 256
QBLOCK = 128
MIX_C = MIX // 2
MIX_D = MIX - MIX_C
POOL_WINDOWS = (2, 4, 8, 16)
N_POOL_GROUPS = len(POOL_WINDOWS)
C_GROUP = MIX_C // N_POOL_GROUPS
POOL_BUF = max(POOL_WINDOWS) - 1
CHUNK = 128
D_GROUPS = 4
D_GROUP_W = MIX_D // D_GROUPS
D_FF = 4 * D_MODEL
N_EVEN = (DEPTH + 1) // 2
N_ODD = DEPTH // 2
ALPHA = (2 * DEPTH) ** 0.25
BETA = (8 * DEPTH) ** -0.25
EPS = 1e-5
E_SIZES = (2 * H_A * DA, 2 * H_A * DA, H_A * DV_A, H_B * DB, DB, DB, HI * DI, DI, HI)
E_COLS = sum(E_SIZES)
O_COLS = MIX_C + 2 * MIX_D

kernel_name = 'hybrid_diffattn_dsa_pool_sgu_step'


def _layernorm(x, g, b):
    xf = x.astype(jnp.float32)
    mu = jnp.mean(xf, -1, keepdims=True)
    var = jnp.mean(jnp.square(xf - mu), -1, keepdims=True)
    return ((xf - mu) * lax.rsqrt(var + EPS) * g + b).astype(x.dtype)


def _rmsnorm(x, g):
    xf = x.astype(jnp.float32)
    return (xf * lax.rsqrt(jnp.mean(xf * xf, -1, keepdims=True) + EPS) * g).astype(x.dtype)


def _split(h, sizes):
    cuts = [int(c) for c in np.cumsum(sizes)[:-1]]
    return jnp.split(h, cuts, axis=-1)


def _to_blocks(x, nblk):
    return jnp.moveaxis(x.reshape((x.shape[0], nblk, -1) + x.shape[2:]), 1, 0)


def _gather_pages(pool, page_table):
    g = pool[page_table]
    return g.reshape((page_table.shape[0], page_table.shape[1] * pool.shape[1]) + pool.shape[2:])


def _mlp(x, w1, w2):
    h = jax.nn.relu(x @ w1)
    return (h * h) @ w2


def _attn_block(q_a, q_b, q_i, w_i, q_pos, k1, k2, va, kb, vb, kidx, lam, subln_g, lam_init, topk):
    B, Q = q_a.shape[:2]
    L = k1.shape[1]
    neg = -jnp.inf
    k_pos = jnp.arange(L)
    causal = k_pos[None, :] <= q_pos[:, None]
    s1 = jnp.einsum('bqhd,bkhd->bhqk', q_a[..., :DA], k1, preferred_element_type=jnp.float32) * DA ** -0.5
    s2 = jnp.einsum('bqhd,bkhd->bhqk', q_a[..., DA:], k2, preferred_element_type=jnp.float32) * DA ** -0.5
    p1 = jax.nn.softmax(jnp.where(causal, s1, neg), axis=-1)
    p2 = jax.nn.softmax(jnp.where(causal, s2, neg), axis=-1)
    att = (p1 - lam * p2).astype(va.dtype)
    o_a = jnp.einsum('bhqk,bkhd->bqhd', att, va)
    o_a = _rmsnorm(o_a, subln_g) * (1.0 - lam_init)
    dots = jnp.einsum('bqhd,bkd->bqhk', q_i, kidx, preferred_element_type=jnp.float32) * DI ** -0.5
    score = jnp.einsum('bqh,bqhk->bqk', w_i.astype(jnp.float32), jax.nn.relu(dots))
    score = jnp.where(causal, score, neg)
    _, idx = lax.top_k(score, topk)
    sel_ok = idx <= q_pos[None, :, None]
    take = jax.vmap(lambda m, i: m[i])
    kb_sel = take(kb, idx)
    vb_sel = take(vb, idx)
    sb = jnp.einsum('bqhd,bqkd->bhqk', q_b, kb_sel, preferred_element_type=jnp.float32) * DB ** -0.5
    pb = jax.nn.softmax(jnp.where(sel_ok[:, None], sb, neg), axis=-1).astype(vb.dtype)
    o_b = jnp.einsum('bhqk,bqkd->bqhd', pb, vb_sel)
    return jnp.concatenate([o_a.reshape(B, Q, MIX_A), o_b.reshape(B, Q, MIX_B)], -1)


def _even_mixer(x, past_a, past_b, w_in, lam_p, subln_g, w_out, lam_init):
    B, T, _ = x.shape
    q_a, k_a, v_a, q_b, k_b, v_b, q_i, k_i, w_i = _split(x @ w_in, E_SIZES)
    new_a = jnp.concatenate([k_a.reshape(B, T, H_A, 2 * DA), v_a.reshape(B, T, H_A, DV_A)], -1)
    new_b = jnp.concatenate([k_b, v_b, k_i], -1)
    keys_a = new_a if past_a is None else jnp.concatenate([past_a.astype(new_a.dtype), new_a], 1)
    keys_b = new_b if past_b is None else jnp.concatenate([past_b.astype(new_b.dtype), new_b], 1)
    L = keys_a.shape[1]
    topk = min(TOPK_MAX, L // 4)
    k1, k2, va = keys_a[..., :DA], keys_a[..., DA:2 * DA], keys_a[..., 2 * DA:]
    kb, vb, kidx = keys_b[..., :DB], keys_b[..., DB:2 * DB], keys_b[..., 2 * DB:]
    lp = lam_p.astype(jnp.float32)
    lam = jnp.exp(jnp.sum(lp[0] * lp[1])) - jnp.exp(jnp.sum(lp[2] * lp[3])) + lam_init
    q_pos = (L - T) + jnp.arange(T)
    qb = min(QBLOCK, T)
    nblk = T // qb
    blocks = (_to_blocks(q_a.reshape(B, T, H_A, 2 * DA), nblk),
              _to_blocks(q_b.reshape(B, T, H_B, DB), nblk),
              _to_blocks(q_i.reshape(B, T, HI, DI), nblk),
              _to_blocks(w_i * HI ** -0.5, nblk),
              q_pos.reshape(nblk, qb))
    out = lax.map(lambda blk: _attn_block(*blk, k1, k2, va, kb, vb, kidx, lam, subln_g, lam_init, topk), blocks)
    out = jnp.moveaxis(out, 0, 1).reshape(B, T, MIX)
    return out @ w_out, new_a, new_b


def _odd_mixer(x, prev, start, w_in, w_pool, pool_scale, sgu_g, sgu_b, w_s, b_s, w_out):
    B, T, _ = x.shape
    xc, z = jnp.split(x @ w_in, [MIX_C], axis=-1)
    u, v = jnp.split(jax.nn.gelu(z), 2, axis=-1)
    ext = jnp.concatenate([prev.astype(xc.dtype), xc], 1)
    n_prev = prev.shape[1]
    cs = jnp.cumsum(ext.astype(jnp.float32), axis=1)
    cs = jnp.concatenate([jnp.zeros_like(cs[:, :1]), cs], 1)
    csg = cs.reshape(B, -1, N_POOL_GROUPS, C_GROUP)
    end = n_prev + 1 + jnp.arange(T)
    pos = start + jnp.arange(T)
    means = []
    for g, w in enumerate(POOL_WINDOWS):
        s = csg[:, end, g] - csg[:, end - w, g]
        cnt = jnp.minimum(w, pos + 1).astype(jnp.float32)
        means.append(s / cnt[None, :, None])
    pooled = jnp.stack(means, 2).astype(xc.dtype) - xc.reshape(B, T, N_POOL_GROUPS, C_GROUP)
    c_out = jnp.einsum('btgc,gcd->btgd', pooled, w_pool).reshape(B, T, MIX_C) * pool_scale
    new_prev = ext[:, -POOL_BUF:]
    vn = _layernorm(v, sgu_g, sgu_b)
    n = min(T, CHUNK)
    ws = jnp.where(jnp.tril(jnp.ones((n, n), bool)), w_s[:, :n, :n], 0)
    vc = vn.reshape(B, T // n, n, D_GROUPS, D_GROUP_W)
    s = jnp.einsum('gij,bkjgc->bkigc', ws, vc) + b_s[:, :n].T[None, None, :, :, None]
    d_out = u * s.reshape(B, T, MIX_D)
    y = jnp.concatenate([c_out, d_out], -1) @ w_out
    return y, new_prev, vn


def setup_inputs(seed: int = 0) -> dict:
    key = jax.random.key(seed)
    ks = jax.random.split(key, 24)
    n_pages = PAST_LEN // PAGE_SIZE
    n_used = DEC_BATCH * n_pages
    n_pool = n_used + max(1, n_used // 4)

    def nrm(k, shape, s):
        return jax.random.normal(k, shape, jnp.float32) * s

    x_prompt = nrm(ks[0], (BATCH, SEQ, D_MODEL), 1.0)
    x_sample = nrm(ks[1], (DEC_BATCH, DEC_SEQ, D_MODEL), 1.0)
    cache_a = nrm(ks[2], (N_EVEN, n_pool, PAGE_SIZE, H_A, 2 * DA + DV_A), 1.0)
    cache_b = nrm(ks[3], (N_EVEN, n_pool, PAGE_SIZE, 2 * DB + DI), 1.0)
    state_pool = nrm(ks[4], (N_ODD, DEC_BATCH, POOL_BUF, MIX_C), 1.0)
    page_table = jax.random.permutation(ks[5], n_pool)[:n_used].reshape(DEC_BATCH, n_pages).astype(jnp.int32)
    col_scale = jnp.concatenate([jnp.full((s,), BETA if j in (2, 5) else 1.0, jnp.float32)
                                 for j, s in enumerate(E_SIZES)])
    w_in_e = nrm(ks[6], (N_EVEN, D_MODEL, E_COLS), D_MODEL ** -0.5) * col_scale
    lam_e = nrm(ks[7], (N_EVEN, 4, DA), 0.1)
    subln_g = 1.0 + nrm(ks[8], (N_EVEN, 2 * DA), 0.05)
    w_out_e = nrm(ks[9], (N_EVEN, MIX, D_MODEL), MIX ** -0.5 * BETA)
    w_in_o = nrm(ks[10], (N_ODD, D_MODEL, O_COLS), D_MODEL ** -0.5)
    w_pool = nrm(ks[11], (N_ODD, N_POOL_GROUPS, C_GROUP, C_GROUP), C_GROUP ** -0.5)
    pool_scale = 1.0 + nrm(ks[12], (N_ODD, MIX_C), 0.05)
    sgu_g = 1.0 + nrm(ks[13], (N_ODD, MIX_D), 0.05)
    sgu_b = nrm(ks[14], (N_ODD, MIX_D), 0.02)
    w_s = nrm(ks[15], (N_ODD, D_GROUPS, CHUNK, CHUNK), CHUNK ** -0.5)
    b_s = 1.0 + nrm(ks[16], (N_ODD, D_GROUPS, CHUNK), 0.05)
    w_out_o = nrm(ks[17], (N_ODD, MIX, D_MODEL), MIX ** -0.5 * BETA)
    w_mlp1 = nrm(ks[18], (DEPTH, D_MODEL, D_FF), D_MODEL ** -0.5)
    w_mlp2 = nrm(ks[19], (DEPTH, D_FF, D_MODEL), D_FF ** -0.5 * BETA)
    ln_g = 1.0 + nrm(ks[20], (DEPTH, 2, D_MODEL), 0.05)
    ln_b = nrm(ks[21], (DEPTH, 2, D_MODEL), 0.02)
    return {'x_prompt': x_prompt, 'x_sample': x_sample, 'cache_a': cache_a, 'cache_b': cache_b,
            'state_pool': state_pool, 'page_table': page_table, 'w_in_e': w_in_e, 'lam_e': lam_e,
            'subln_g': subln_g, 'w_out_e': w_out_e, 'w_in_o': w_in_o, 'w_pool': w_pool,
            'pool_scale': pool_scale, 'sgu_g': sgu_g, 'sgu_b': sgu_b, 'w_s': w_s, 'b_s': b_s,
            'w_out_o': w_out_o, 'w_mlp1': w_mlp1, 'w_mlp2': w_mlp2, 'ln_g': ln_g, 'ln_b': ln_b}


def reference(x_prompt, x_sample, cache_a, cache_b, state_pool, page_table, w_in_e, lam_e, subln_g,
              w_out_e, w_in_o, w_pool, pool_scale, sgu_g, sgu_b, w_s, b_s, w_out_o, w_mlp1, w_mlp2,
              ln_g, ln_b):
    xp, xs = x_prompt, x_sample
    a_p, b_p, pool_p, a_s, b_s_new, pool_s, v_s = [], [], [], [], [], [], []
    for l in range(DEPTH):
        i = l // 2
        if l % 2 == 0:
            lam_init = 0.8 - 0.6 * math.exp(-0.3 * l)
            mp, na, nb = _even_mixer(xp, None, None, w_in_e[i], lam_e[i], subln_g[i], w_out_e[i], lam_init)
            ms, nas, nbs = _even_mixer(xs, _gather_pages(cache_a[i], page_table),
                                       _gather_pages(cache_b[i], page_table),
                                       w_in_e[i], lam_e[i], subln_g[i], w_out_e[i], lam_init)
            a_p.append(na); b_p.append(nb); a_s.append(nas); b_s_new.append(nbs)
        else:
            prev0 = jnp.zeros((xp.shape[0], POOL_BUF, MIX_C), xp.dtype)
            mp, npool, _ = _odd_mixer(xp, prev0, 0, w_in_o[i], w_pool[i], pool_scale[i], sgu_g[i],
                                      sgu_b[i], w_s[i], b_s[i], w_out_o[i])
            ms, npools, nvs = _odd_mixer(xs, state_pool[i], PAST_LEN, w_in_o[i], w_pool[i], pool_scale[i],
                                         sgu_g[i], sgu_b[i], w_s[i], b_s[i], w_out_o[i])
            pool_p.append(npool); pool_s.append(npools); v_s.append(nvs)
        xp = _layernorm(ALPHA * xp + mp, ln_g[l, 0], ln_b[l, 0])
        xp = _layernorm(ALPHA * xp + _mlp(xp, w_mlp1[l], w_mlp2[l]), ln_g[l, 1], ln_b[l, 1])
        xs = _layernorm(ALPHA * xs + ms, ln_g[l, 0], ln_b[l, 0])
        xs = _layernorm(ALPHA * xs + _mlp(xs, w_mlp1[l], w_mlp2[l]), ln_g[l, 1], ln_b[l, 1])
    return (xp, xs, jnp.stack(a_p), jnp.stack(b_p), jnp.stack(pool_p), jnp.stack(a_s),
            jnp.stack(b_s_new), jnp.stack(pool_s), jnp.stack(v_s))
```

```cpp
#include <hip/hip_runtime.h>
#include <cstdio>
#include <cstdint>
namespace orc {
constexpr int D = 1024, MP = 16384, MS = 512, M = MP + MS, SEQ = 4096, PAST = 2048;
constexpr int ECOLS = 2888, OCOLS = 1536, FF = 4096;
constexpr float ALPHA = 1.4142135623730951f;
constexpr float LN_EPS = 1e-5f;
constexpr size_t O_Y = 0, O_NAP = (size_t)M * D, O_NBP = O_NAP + (size_t)MP * 1024, O_NPP = O_NBP + (size_t)MP * 320,
                 O_NAS = O_NPP + 4 * 15 * 512, O_NBS = O_NAS + (size_t)MS * 1024, O_NPS = O_NBS + (size_t)MS * 320, O_NVS = O_NPS + 128 * 15 * 512,
                 O_END = O_NVS + (size_t)MS * 512;

template <int MODE>
__global__ __launch_bounds__(256) void gemm_f32(const float* __restrict__ A, int lda, const float* __restrict__ B, int ldb, float* __restrict__ C, int ldc,
                                                int N, int K, const float* __restrict__ R, int ldr, float alpha) {
    __shared__ float As[16][68];
    __shared__ float Bs[16][68];
    const int bm = blockIdx.y * 64, bn = blockIdx.x * 64, tx = threadIdx.x % 16, ty = threadIdx.x / 16;
    float acc[4][4];
#pragma unroll
    for (int i = 0; i < 4; ++i)
#pragma unroll
        for (int j = 0; j < 4; ++j) acc[i][j] = 0.f;
    for (int k0 = 0; k0 < K; k0 += 16) {
        for (int i = threadIdx.x; i < 1024; i += 256) { const int m = i / 16, k = i % 16; As[k][m] = A[(size_t)(bm + m) * lda + k0 + k]; }
        for (int i = threadIdx.x; i < 1024; i += 256) { const int k = i / 64, n = i % 64; Bs[k][n] = (bn + n < N) ? B[(size_t)(k0 + k) * ldb + bn + n] : 0.f; }
        __syncthreads();
#pragma unroll
        for (int k = 0; k < 16; ++k) {
            float a[4], b[4];
#pragma unroll
            for (int i = 0; i < 4; ++i) { a[i] = As[k][ty * 4 + i]; b[i] = Bs[k][tx * 4 + i]; }
#pragma unroll
            for (int i = 0; i < 4; ++i)
#pragma unroll
                for (int j = 0; j < 4; ++j) acc[i][j] += a[i] * b[j];
        }
        __syncthreads();
    }
#pragma unroll
    for (int i = 0; i < 4; ++i)
#pragma unroll
        for (int j = 0; j < 4; ++j) {
            const int r = bm + ty * 4 + i, c = bn + tx * 4 + j;
            if (c < N) {
                float v = acc[i][j];
                if (MODE == 1) { v = v > 0.f ? v : 0.f; v = v * v; }
                if (MODE == 2) v = alpha * R[(size_t)r * ldr + c] + v;
                C[(size_t)r * ldc + c] = v;
            }
        }
}

__device__ __forceinline__ float block_sum(float v, float* red) {
    __syncthreads();
    red[threadIdx.x] = v; __syncthreads();
    for (int s = 128; s > 0; s >>= 1) { if ((int)threadIdx.x < s) red[threadIdx.x] += red[threadIdx.x + s]; __syncthreads(); }
    const float r = red[0]; __syncthreads(); return r;
}
__device__ __forceinline__ float block_max(float v, float* red) {
    __syncthreads();
    red[threadIdx.x] = v; __syncthreads();
    for (int s = 128; s > 0; s >>= 1) { if ((int)threadIdx.x < s) red[threadIdx.x] = fmaxf(red[threadIdx.x], red[threadIdx.x + s]); __syncthreads(); }
    const float r = red[0]; __syncthreads(); return r;
}
__global__ __launch_bounds__(256) void ln_rows(const float* __restrict__ V, int ldv, const float* __restrict__ g, const float* __restrict__ b, float* __restrict__ out, int ldo, int N) {
    __shared__ float red[256];
    const float* v = V + (size_t)blockIdx.x * ldv;
    float s = 0.f; for (int c = threadIdx.x; c < N; c += 256) s += v[c];
    const float mean = block_sum(s, red) / N;
    float q = 0.f; for (int c = threadIdx.x; c < N; c += 256) { const float d = v[c] - mean; q += d * d; }
    const float rstd = rsqrtf(block_sum(q, red) / N + LN_EPS);
    for (int c = threadIdx.x; c < N; c += 256) out[(size_t)blockIdx.x * ldo + c] = (v[c] - mean) * rstd * g[c] + b[c];
}
__device__ __forceinline__ void row_info(int row, bool& samp, int& b, int& t, int& nk) {
    samp = row >= MP;
    if (!samp) { b = row / SEQ; t = row % SEQ; nk = t + 1; } else { const int r = row - MP; b = r / 4; t = r % 4; nk = PAST + t + 1; }
}
__device__ __forceinline__ const float* pe_keyrow(const float* PE, bool samp, int b, int j) {
    return PE + (size_t)(samp ? (MP + 4 * b + (j - PAST)) : (b * SEQ + j)) * ECOLS;
}
__global__ __launch_bounds__(256) void diff_attn(const float* __restrict__ PE, const float* __restrict__ cache_a, const int* __restrict__ page_table,
                                                 const float* __restrict__ lam_e, const float* __restrict__ subln_g, float* __restrict__ OUT) {
    __shared__ float s1[4096], s2[4096], q[128], red[256], osum[256];
    const int row = blockIdx.x, h = blockIdx.y, tid = threadIdx.x;
    bool samp; int b, t, nk; row_info(row, samp, b, t, nk);
    if (tid < 128) q[tid] = PE[(size_t)row * ECOLS + h * 128 + tid];
    __syncthreads();
    float m1 = -INFINITY, m2 = -INFINITY;
    for (int j = tid; j < nk; j += 256) {
        const float* kp;
        if (samp && j < PAST) kp = cache_a + ((size_t)page_table[b * 16 + j / 128] * 128 + (j % 128)) * 1024 + h * 256;
        else kp = pe_keyrow(PE, samp, b, j) + 512 + h * 128;
        float a = 0.f, c = 0.f;
        for (int d = 0; d < 64; ++d) { a += q[d] * kp[d]; c += q[64 + d] * kp[64 + d]; }
        a *= 0.125f; c *= 0.125f; s1[j] = a; s2[j] = c; m1 = fmaxf(m1, a); m2 = fmaxf(m2, c);
    }
    m1 = block_max(m1, red); m2 = block_max(m2, red);
    float l1 = 0.f, l2 = 0.f;
    for (int j = tid; j < nk; j += 256) { const float e1 = expf(s1[j] - m1), e2 = expf(s2[j] - m2); s1[j] = e1; s2[j] = e2; l1 += e1; l2 += e2; }
    l1 = block_sum(l1, red); l2 = block_sum(l2, red);
    float la = 0.f, lb = 0.f;
    for (int d = 0; d < 64; ++d) { la += lam_e[d] * lam_e[64 + d]; lb += lam_e[128 + d] * lam_e[192 + d]; }
    const float lam = expf(la) - expf(lb) + 0.2f;
    for (int j = tid; j < nk; j += 256) s1[j] = s1[j] / l1 - lam * (s2[j] / l2);
    __syncthreads();
    const int d = tid & 127, half = tid >> 7;
    float o = 0.f;
    for (int j = half; j < nk; j += 2) {
        const float* vp;
        if (samp && j < PAST) vp = cache_a + ((size_t)page_table[b * 16 + j / 128] * 128 + (j % 128)) * 1024 + h * 256 + 128;
        else vp = pe_keyrow(PE, samp, b, j) + 1024 + h * 128;
        o += s1[j] * vp[d];
    }
    osum[tid] = o; __syncthreads();
    if (tid < 128) o = osum[tid] + osum[tid + 128];
    const float ss = block_sum(tid < 128 ? o * o : 0.f, red);
    const float r = rsqrtf(ss / 128.f + LN_EPS);
    if (tid < 128) OUT[(size_t)row * 1024 + h * 128 + tid] = o * r * subln_g[tid] * 0.8f;
}
__global__ __launch_bounds__(256) void idx_scores(const float* __restrict__ PE, const float* __restrict__ cache_b, const int* __restrict__ page_table, float* __restrict__ S) {
    __shared__ float q[512], w[8];
    const int row = blockIdx.x, tid = threadIdx.x;
    bool samp; int b, t, nk; row_info(row, samp, b, t, nk);
    for (int i = tid; i < 512; i += 256) q[i] = PE[(size_t)row * ECOLS + 2304 + i];
    if (tid < 8) w[tid] = PE[(size_t)row * ECOLS + 2880 + tid] * 0.35355339059327373f;
    __syncthreads();
    for (int j = tid; j < nk; j += 256) {
        const float* kp;
        if (samp && j < PAST) kp = cache_b + ((size_t)page_table[b * 16 + j / 128] * 128 + (j % 128)) * 320 + 256;
        else kp = pe_keyrow(PE, samp, b, j) + 2816;
        float sc = 0.f;
        for (int h = 0; h < 8; ++h) { float a = 0.f; for (int d = 0; d < 64; ++d) a += q[h * 64 + d] * kp[d]; a *= 0.125f; sc += w[h] * fmaxf(a, 0.f); }
        S[(size_t)row * 4096 + j] = sc;
    }
}
__global__ __launch_bounds__(256) void topk_sel(const float* __restrict__ S, unsigned char* __restrict__ SEL) {
    __shared__ float sc[4096];
    const int row = blockIdx.x, tid = threadIdx.x;
    bool samp; int b, t, nk; row_info(row, samp, b, t, nk);
    for (int j = tid; j < nk; j += 256) sc[j] = S[(size_t)row * 4096 + j];
    __syncthreads();
    for (int j = tid; j < nk; j += 256) {
        unsigned char s = 1;
        if (nk > 256) { const float v = sc[j]; int rank = 0; for (int k = 0; k < nk; ++k) { const float u = sc[k]; rank += (u > v || (u == v && k < j)) ? 1 : 0; } s = rank < 256 ? 1 : 0; }
        SEL[(size_t)row * 4096 + j] = s;
    }
}
__global__ __launch_bounds__(256) void sparse_attn(const float* __restrict__ PE, const float* __restrict__ cache_b, const int* __restrict__ page_table,
                                                   const unsigned char* __restrict__ SEL, float* __restrict__ OUT) {
    __shared__ float s[4096], q[128], red[256], osum[256];
    const int row = blockIdx.x, h = blockIdx.y, tid = threadIdx.x;
    bool samp; int b, t, nk; row_info(row, samp, b, t, nk);
    if (tid < 128) q[tid] = PE[(size_t)row * ECOLS + 1536 + h * 128 + tid];
    __syncthreads();
    float mx = -INFINITY;
    for (int j = tid; j < nk; j += 256) {
        float a = -INFINITY;
        if (SEL[(size_t)row * 4096 + j]) {
            const float* kp;
            if (samp && j < PAST) kp = cache_b + ((size_t)page_table[b * 16 + j / 128] * 128 + (j % 128)) * 320;
            else kp = pe_keyrow(PE, samp, b, j) + 2048;
            a = 0.f; for (int d = 0; d < 128; ++d) a += q[d] * kp[d];
            a *= 0.08838834764831845f;
        }
        s[j] = a; mx = fmaxf(mx, a);
    }
    mx = block_max(mx, red);
    float l = 0.f;
    for (int j = tid; j < nk; j += 256) { const float e = expf(s[j] - mx); s[j] = e; l += e; }
    l = block_sum(l, red);
    const int d = tid & 127, half = tid >> 7;
    float o = 0.f;
    for (int j = half; j < nk; j += 2) {
        const float p = s[j];
        if (p != 0.f) {
            const float* vp;
            if (samp && j < PAST) vp = cache_b + ((size_t)page_table[b * 16 + j / 128] * 128 + (j % 128)) * 320 + 128;
            else vp = pe_keyrow(PE, samp, b, j) + 2176;
            o += p * vp[d];
        }
    }
    osum[tid] = o; __syncthreads();
    if (tid < 128) OUT[(size_t)row * 1024 + 512 + h * 128 + tid] = (osum[tid] + osum[tid + 128]) / l;
}
__global__ void emit_cache_rows(const float* __restrict__ PE, float* __restrict__ out) {
    const int row = blockIdx.x;
    float* na = out + (row < MP ? O_NAP + (size_t)row * 1024 : O_NAS + (size_t)(row - MP) * 1024);
    float* nb = out + (row < MP ? O_NBP + (size_t)row * 320 : O_NBS + (size_t)(row - MP) * 320);
    const float* pe = PE + (size_t)row * ECOLS;
    for (int i = threadIdx.x; i < 1024; i += blockDim.x) { const int h = i / 256, c = i % 256; na[i] = c < 128 ? pe[512 + h * 128 + c] : pe[1024 + h * 128 + (c - 128)]; }
    for (int i = threadIdx.x; i < 320; i += blockDim.x) nb[i] = i < 256 ? pe[2048 + i] : pe[2816 + (i - 256)];
}
__device__ __forceinline__ float gelu_tanh(float x) { const float u = 0.7978845608028654f * (x + 0.044715f * x * x * x); return 0.5f * x * (1.f + tanhf(u)); }
__global__ __launch_bounds__(256) void odd_pre(const float* __restrict__ PO, const float* __restrict__ state_pool, float* __restrict__ POOLED, float* __restrict__ U, float* __restrict__ GV) {
    const int row = blockIdx.x;
    bool samp; int b, t, nk; row_info(row, samp, b, t, nk);
    for (int c = threadIdx.x; c < 512; c += 256) {
        const int g = c / 128, w = 2 << g;
        float s = 0.f; int cnt;
        if (!samp) { cnt = w < t + 1 ? w : t + 1; for (int k = 0; k < cnt; ++k) s += PO[(size_t)(row - k) * OCOLS + c]; }
        else { cnt = w; for (int k = 0; k < w; ++k) { const int e = 15 + t - k;
                   s += e >= 15 ? PO[(size_t)(MP + 4 * b + (e - 15)) * OCOLS + c] : state_pool[((size_t)b * 15 + e) * 512 + c]; } }
        POOLED[(size_t)row * 512 + c] = s / (float)cnt - PO[(size_t)row * OCOLS + c];
        U[(size_t)row * 512 + c] = gelu_tanh(PO[(size_t)row * OCOLS + 512 + c]);
        GV[(size_t)row * 512 + c] = gelu_tanh(PO[(size_t)row * OCOLS + 1024 + c]);
    }
}
__global__ __launch_bounds__(256) void odd_mix(const float* __restrict__ POOLED, const float* __restrict__ U, const float* __restrict__ VN, const float* __restrict__ w_pool,
                                               const float* __restrict__ pool_scale, const float* __restrict__ w_s, const float* __restrict__ b_s, float* __restrict__ MIXO) {
    __shared__ float p[512];
    const int row = blockIdx.x;
    bool samp; int b, t, nk; row_info(row, samp, b, t, nk);
    for (int c = threadIdx.x; c < 512; c += 256) p[c] = POOLED[(size_t)row * 512 + c];
    __syncthreads();
    const int i = samp ? t : (t % 128), row0 = row - i;
    for (int c = threadIdx.x; c < 512; c += 256) {
        const int g = c / 128, d = c % 128;
        float a = 0.f; for (int k = 0; k < 128; ++k) a += p[g * 128 + k] * w_pool[((size_t)g * 128 + k) * 128 + d];
        MIXO[(size_t)row * 1024 + c] = a * pool_scale[c];
        float s = b_s[g * 128 + i];
        for (int j = 0; j <= i; ++j) s += w_s[((size_t)g * 128 + i) * 128 + j] * VN[(size_t)(row0 + j) * 512 + c];
        MIXO[(size_t)row * 1024 + 512 + c] = U[(size_t)row * 512 + c] * s;
    }
}
__global__ void odd_outputs(const float* __restrict__ PO, const float* __restrict__ state_pool, const float* __restrict__ VN, float* __restrict__ out) {
    const int i = blockIdx.x * blockDim.x + threadIdx.x;
    if (i < 4 * 15 * 512) { const int b = i / (15 * 512), r = (i / 512) % 15, c = i % 512; out[O_NPP + i] = PO[(size_t)(b * SEQ + SEQ - 15 + r) * OCOLS + c]; }
    if (i < 128 * 15 * 512) { const int b = i / (15 * 512), r = (i / 512) % 15, c = i % 512; const int e = r + 4;
        out[O_NPS + i] = e >= 15 ? PO[(size_t)(MP + 4 * b + (e - 15)) * OCOLS + c] : state_pool[((size_t)b * 15 + e) * 512 + c]; }
    if (i < MS * 512) out[O_NVS + i] = VN[(size_t)MP * 512 + i];
}

struct Ws { float *X, *PE, *S, *OUT, *V, *X1, *H, *PO, *POOLED, *U, *GV, *VN, *MIXO; unsigned char* SEL; };
inline size_t carve(char* base, Ws& w) {
    size_t off = 0; auto take = [&](size_t bytes) { char* p = base + off; off += (bytes + 255) & ~(size_t)255; return p; };
    w.X = (float*)take((size_t)M * D * 4); w.PE = (float*)take((size_t)M * ECOLS * 4); w.S = (float*)take((size_t)M * 4096 * 4); w.SEL = (unsigned char*)take((size_t)M * 4096);
    w.OUT = (float*)take((size_t)M * D * 4); w.V = (float*)take((size_t)M * D * 4); w.X1 = (float*)take((size_t)M * D * 4); w.H = (float*)take((size_t)M * FF * 4);
    w.PO = (float*)take((size_t)M * OCOLS * 4); w.POOLED = (float*)take((size_t)M * 512 * 4); w.U = (float*)take((size_t)M * 512 * 4); w.GV = (float*)take((size_t)M * 512 * 4);
    w.VN = (float*)take((size_t)M * 512 * 4); w.MIXO = (float*)take((size_t)M * D * 4);
    return off;
}
inline void forward(void* const* d_in, float* out, const Ws& w, hipStream_t st) {
    const float* x_prompt = (const float*)d_in[0]; const float* x_sample = (const float*)d_in[1]; const float* cache_a = (const float*)d_in[2]; const float* cache_b = (const float*)d_in[3];
    const float* state_pool = (const float*)d_in[4]; const int* page_table = (const int*)d_in[5]; const float* w_in_e = (const float*)d_in[6]; const float* lam_e = (const float*)d_in[7];
    const float* subln_g = (const float*)d_in[8]; const float* w_out_e = (const float*)d_in[9]; const float* w_in_o = (const float*)d_in[10]; const float* w_pool = (const float*)d_in[11];
    const float* pool_scale = (const float*)d_in[12]; const float* sgu_g = (const float*)d_in[13]; const float* sgu_b = (const float*)d_in[14]; const float* w_s = (const float*)d_in[15];
    const float* b_s = (const float*)d_in[16]; const float* w_out_o = (const float*)d_in[17]; const float* w_mlp1 = (const float*)d_in[18]; const float* w_mlp2 = (const float*)d_in[19];
    const float* ln_g = (const float*)d_in[20]; const float* ln_b = (const float*)d_in[21];
    hipMemcpyAsync(w.X, x_prompt, (size_t)MP * D * 4, hipMemcpyDeviceToDevice, st);
    hipMemcpyAsync(w.X + (size_t)MP * D, x_sample, (size_t)MS * D * 4, hipMemcpyDeviceToDevice, st);
    gemm_f32<0><<<dim3((ECOLS + 63) / 64, M / 64), 256, 0, st>>>(w.X, D, w_in_e, ECOLS, w.PE, ECOLS, ECOLS, D, nullptr, 0, 0.f);
    emit_cache_rows<<<M, 256, 0, st>>>(w.PE, out);
    diff_attn<<<dim3(M, 4), 256, 0, st>>>(w.PE, cache_a, page_table, lam_e, subln_g, w.OUT);
    idx_scores<<<M, 256, 0, st>>>(w.PE, cache_b, page_table, w.S);
    topk_sel<<<M, 256, 0, st>>>(w.S, w.SEL);
    sparse_attn<<<dim3(M, 4), 256, 0, st>>>(w.PE, cache_b, page_table, w.SEL, w.OUT);
    gemm_f32<2><<<dim3(D / 64, M / 64), 256, 0, st>>>(w.OUT, D, w_out_e, D, w.V, D, D, D, w.X, D, ALPHA);
    ln_rows<<<M, 256, 0, st>>>(w.V, D, ln_g, ln_b, w.X1, D, D);
    gemm_f32<1><<<dim3(FF / 64, M / 64), 256, 0, st>>>(w.X1, D, w_mlp1, FF, w.H, FF, FF, D, nullptr, 0, 0.f);
    gemm_f32<2><<<dim3(D / 64, M / 64), 256, 0, st>>>(w.H, FF, w_mlp2, D, w.V, D, D, FF, w.X1, D, ALPHA);
    ln_rows<<<M, 256, 0, st>>>(w.V, D, ln_g + D, ln_b + D, w.X, D, D);
    gemm_f32<0><<<dim3(OCOLS / 64, M / 64), 256, 0, st>>>(w.X, D, w_in_o, OCOLS, w.PO, OCOLS, OCOLS, D, nullptr, 0, 0.f);
    odd_pre<<<M, 256, 0, st>>>(w.PO, state_pool, w.POOLED, w.U, w.GV);
    ln_rows<<<M, 256, 0, st>>>(w.GV, 512, sgu_g, sgu_b, w.VN, 512, 512);
    odd_mix<<<M, 256, 0, st>>>(w.POOLED, w.U, w.VN, w_pool, pool_scale, w_s, b_s, w.MIXO);
    odd_outputs<<<(128 * 15 * 512 + 255) / 256, 256, 0, st>>>(w.PO, state_pool, w.VN, out);
    gemm_f32<2><<<dim3(D / 64, M / 64), 256, 0, st>>>(w.MIXO, D, w_out_o, D, w.V, D, D, D, w.X, D, ALPHA);
    ln_rows<<<M, 256, 0, st>>>(w.V, D, ln_g + 2 * D, ln_b + 2 * D, w.X1, D, D);
    gemm_f32<1><<<dim3(FF / 64, M / 64), 256, 0, st>>>(w.X1, D, w_mlp1 + (size_t)D * FF, FF, w.H, FF, FF, D, nullptr, 0, 0.f);
    gemm_f32<2><<<dim3(D / 64, M / 64), 256, 0, st>>>(w.H, FF, w_mlp2 + (size_t)FF * D, D, w.V, D, D, FF, w.X1, D, ALPHA);
    ln_rows<<<M, 256, 0, st>>>(w.V, D, ln_g + 3 * D, ln_b + 3 * D, out + O_Y, D, D);
}
}
extern "C" void kernel_launch(void* const* d_in, const int* in_sizes, int n_in, void* d_out, int out_size, void* d_ws, size_t ws_size, hipStream_t stream) {
    orc::Ws w; const size_t need = orc::carve((char*)d_ws, w);
    if (need > ws_size || out_size != (int)orc::O_END) { fprintf(stderr, "kernel_launch: ws %zu need %zu out %d want %zu\n", ws_size, need, out_size, (size_t)orc::O_END); return; }
    orc::forward(d_in, (float*)d_out, w, stream);
}
```

```cpp
#include <hip/hip_runtime.h>
#include <cstdio>
#include <cstdint>
namespace pg8 {
#define PG8_LAS __attribute__((address_space(3)))
typedef unsigned short bf16_t;
typedef short bf16x8 __attribute__((ext_vector_type(8)));
typedef float f32x4 __attribute__((ext_vector_type(4)));
typedef unsigned u32x4 __attribute__((ext_vector_type(4)));
constexpr int BM = 256, BK = 64, HALF = 128, HTB = HALF * BK * 2  , STAGE_BYTES = 8 * HTB, NXCD = 8, WGM = 8;

__host__ __device__ __forceinline__ int lds_byte(int r, int c) { const int st = (r >> 4) * 2 + (c >> 5), rr = r & 15, cc = c & 31, ob = rr * 64 + cc * 2; return st * 1024 + (ob ^ (((ob >> 9) & 1) << 5)); }
__host__ __device__ __forceinline__ void stage_rc(int b, int& R, int& C) { const int st = b / 1024, sb = b % 1024, swz = sb ^ (((sb >> 9) & 1) << 5); R = (st >> 1) * 16 + swz / 64; C = (st & 1) * 32 + (swz % 64) / 2; }
__host__ __device__ __forceinline__ int perm32(int rho) { const int n = rho >> 4, i = rho & 15; return 8 * (i >> 2) + 4 * n + (i & 3); }

struct Unit { int pm, pn; };
struct Gemm { const bf16_t* A; const bf16_t* Bt; int M, N, K; };

struct StaticOrder {
    int nM, nN, nwg, G, c;
    __host__ __device__ void init(int M, int N, int G_, int c_) { nM = M / BM; nN = N / BM; nwg = nM * nN; G = G_; c = c_; }
    __host__ __device__ bool next(int i, Unit& u) const {
        const long L = (long)i * G + c; if (L >= nwg) return false;
        int wgid = (int)L; { const int q = nwg / NXCD, r = nwg % NXCD, xcd = wgid % NXCD, off = wgid / NXCD; wgid = (xcd < r ? xcd * (q + 1) : r * (q + 1) + (xcd - r) * q) + off; }
        const int nig = WGM * nN, gid = wgid / nig, fm = gid * WGM, gsz = (nM - fm) < WGM ? (nM - fm) : WGM;
        u.pm = fm + ((wgid % nig) % gsz); u.pn = (wgid % nig) / gsz; return true;
    }
    __device__ __forceinline__ void a_ready(const Unit&) const {}
    __device__ __forceinline__ void done(const Unit&) const {}
};

__device__ __forceinline__ unsigned cvt_pk_bf16(float lo, float hi) { unsigned r; asm volatile("v_cvt_pk_bf16_f32 %0, %1, %2" : "=v"(r) : "v"(lo), "v"(hi)); return r; }
typedef float f32x2 __attribute__((ext_vector_type(2)));
__device__ __forceinline__ u32x4 pack8s(f32x4 v0, f32x4 v1, float sc) {
    u32x4 w; w.x = cvt_pk_bf16(v0[0] * sc, v0[1] * sc); w.y = cvt_pk_bf16(v0[2] * sc, v0[3] * sc); w.z = cvt_pk_bf16(v1[0] * sc, v1[1] * sc); w.w = cvt_pk_bf16(v1[2] * sc, v1[3] * sc); return w;
}
struct EpiInE {
    static constexpr bool PERM = true, AFTER_DRAIN = false;
    float* na0; float* nb0;
    float* na1; float* nb1;
    bf16_t *QA, *KA, *VA, *QB, *KB, *VB, *QI, *KI; float* WI;
    float c2;
    __device__ __forceinline__ void operator()(const f32x4 (&acc)[2][2][4][2], const Unit& u, int wr, int wc, int fr, int fq) const {
        const int row0 = u.pm * BM + wr * 64 + fr; const bool samp = u.pm >= 64;
        float* na = samp ? na1 : na0; float* nb = samp ? nb1 : nb0;
        const int cb = wc * 32 + 8 * fq;
#pragma unroll
        for (int bj = 0; bj < 2; ++bj) {
            const int blk = 2 * u.pn + bj;
            float* fd = nullptr; int fld = 0, fcol = 0; bf16_t* bd = nullptr; int bld = 0, bcol = 0; float sc = 1.f; bool lane_ok = true; bool widx = false;
            if (blk < 4)       { bd = QA; bld = 512; bcol = blk * 128; sc = c2; }
            else if (blk < 8)  { const int h = blk - 4; fd = na; fld = 1024; fcol = h * 256; bd = KA; bld = 512; bcol = h * 128; }
            else if (blk < 12) { const int h = blk - 8; fd = na; fld = 1024; fcol = h * 256 + 128; bd = VA; bld = 512; bcol = h * 128; }
            else if (blk < 16) { bd = QB; bld = 512; bcol = (blk - 12) * 128; }
            else if (blk == 16) { fd = nb; fld = 320; fcol = 0; bd = KB; bld = 128; bcol = 0; }
            else if (blk == 17) { fd = nb; fld = 320; fcol = 128; bd = VB; bld = 128; bcol = 0; }
            else if (blk < 22) { bd = QI; bld = 512; bcol = (blk - 18) * 128; sc = 0.125f; }
            else if (blk == 22) { fd = nb; fld = 320; fcol = 256; bd = KI; bld = 64; bcol = 0; lane_ok = cb < 64; widx = (cb == 64); }
            else { lane_ok = false; }
#pragma unroll
            for (int ai = 0; ai < 2; ++ai)
#pragma unroll
                for (int m = 0; m < 4; ++m) {
                    const size_t row = (size_t)(row0 + ai * HALF + m * 16);
                    const f32x4 v0 = acc[ai][bj][m][0], v1 = acc[ai][bj][m][1];
                    if (lane_ok) {
                        if (fd) { float* p = fd + row * fld + fcol + cb; *(f32x4*)p = v0; *(f32x4*)(p + 4) = v1; }
                        if (bd) { *(u32x4*)(bd + row * bld + bcol + cb) = pack8s(v0, v1, sc); }
                    }
                    if (widx) { float* p = WI + row * 8; *(f32x4*)p = v0 * 0.35355339059327373f; *(f32x4*)(p + 4) = v1 * 0.35355339059327373f; }
                }
        }
    }
};
struct EpiRes {
    static constexpr bool PERM = false, AFTER_DRAIN = false;
    const float* res0; const float* res1;
    float* V; float alpha;
    __device__ __forceinline__ void operator()(const f32x4 (&acc)[2][2][4][2], const Unit& u, int wr, int wc, int fr, int fq) const {
        const int row0 = u.pm * BM + wr * 64 + fr; const float* res = u.pm >= 64 ? res1 : res0;
        const int col0 = u.pn * BM + wc * 32 + 4 * fq;
#pragma unroll
        for (int ai = 0; ai < 2; ++ai)
#pragma unroll
            for (int m = 0; m < 4; ++m) {
                const size_t off = (size_t)(row0 + ai * HALF + m * 16) * 1024 + col0;
#pragma unroll
                for (int bj = 0; bj < 2; ++bj)
#pragma unroll
                    for (int n = 0; n < 2; ++n) { const f32x4 r = *(const f32x4*)(res + off + bj * HALF + n * 16); *(f32x4*)(V + off + bj * HALF + n * 16) = acc[ai][bj][m][n] + r * alpha; }
            }
    }
};
struct EpiRelu2 {
    static constexpr bool PERM = true, AFTER_DRAIN = false;
    bf16_t* O; int ldc;
    __device__ __forceinline__ void operator()(const f32x4 (&acc)[2][2][4][2], const Unit& u, int wr, int wc, int fr, int fq) const {
        const int row0 = u.pm * BM + wr * 64 + fr, col0 = u.pn * BM + wc * 32 + 8 * fq;
#pragma unroll
        for (int ai = 0; ai < 2; ++ai)
#pragma unroll
            for (int m = 0; m < 4; ++m) { bf16_t* rowp = O + (size_t)(row0 + ai * HALF + m * 16) * ldc + col0;
#pragma unroll
                for (int bj = 0; bj < 2; ++bj) { f32x4 v0 = acc[ai][bj][m][0], v1 = acc[ai][bj][m][1];
#pragma unroll
                    for (int e = 0; e < 4; ++e) { const float a = fmaxf(v0[e], 0.f), b = fmaxf(v1[e], 0.f); v0[e] = a * a; v1[e] = b * b; }
                    *(u32x4*)(rowp + bj * HALF) = pack8s(v0, v1, 1.f); } }
    }
};
__device__ __forceinline__ float gelu_t(float x) {
    const float u = x * (1.0f + 0.044715f * x * x) * (-2.0f * 0.7978845608028654f * 1.4426950408889634f);
    return x * __builtin_amdgcn_rcpf(1.0f + __builtin_amdgcn_exp2f(u));
}
struct EpiInO {
    static constexpr bool PERM = true, AFTER_DRAIN = false;
    float* XC; bf16_t* U; float* GV;
    __device__ __forceinline__ void operator()(const f32x4 (&acc)[2][2][4][2], const Unit& u, int wr, int wc, int fr, int fq) const {
        const int row0 = u.pm * BM + wr * 64 + fr; const int cb = wc * 32 + 8 * fq;
#pragma unroll
        for (int bj = 0; bj < 2; ++bj) {
            const int blk = 2 * u.pn + bj;
#pragma unroll
            for (int ai = 0; ai < 2; ++ai)
#pragma unroll
                for (int m = 0; m < 4; ++m) {
                    const size_t row = (size_t)(row0 + ai * HALF + m * 16);
                    f32x4 v0 = acc[ai][bj][m][0], v1 = acc[ai][bj][m][1];
                    if (blk < 4) { float* p = XC + row * 512 + blk * 128 + cb; *(f32x4*)p = v0; *(f32x4*)(p + 4) = v1; }
                    else {
#pragma unroll
                        for (int e = 0; e < 4; ++e) { v0[e] = gelu_t(v0[e]); v1[e] = gelu_t(v1[e]); }
                        if (blk < 8) *(u32x4*)(U + row * 512 + (blk - 4) * 128 + cb) = pack8s(v0, v1, 1.f);
                        else { float* p = GV + row * 512 + (blk - 8) * 128 + cb; *(f32x4*)p = v0; *(f32x4*)(p + 4) = v1; }
                    }
                }
        }
    }
};
template <class Epi, class Sched, bool ALIGN_EPI = false, bool SP2 = false>
__device__ __forceinline__ void gemm_phase(PG8_LAS unsigned char* lds, const Gemm g, const Sched& S, const Epi& E) {
    const int tid = threadIdx.x, wid = __builtin_amdgcn_readfirstlane(tid >> 6), lane = tid & 63, wr = wid >> 2, wc = wid & 3, fr = lane & 15, fq = lane >> 4;
    const int K = g.K, nt = K / BK;
    unsigned voffA[2], voffB[2];
#pragma unroll
    for (int i = 0; i < 2; ++i) { int R, C; stage_rc(tid * 16 + i * 8192, R, C); const int Rb = Epi::PERM ? ((R & ~31) + perm32(R & 31)) : R;
        voffA[i] = (unsigned)(R * K + C) * 2u; voffB[i] = (unsigned)(Rb * K + C) * 2u; }
    const size_t kstep = (size_t)(BK * 2);
    const size_t hstep = (size_t)HALF * K * 2;
    const size_t tstep = 2 * hstep;
    const unsigned ldsw = (unsigned)wid * 1024u;
    const int aoff = lds_byte(wr * 64 + fr, fq * 8), boff = lds_byte(wc * 32 + fr, fq * 8);
#define PG8_SA(b, h) (((b) * 2 + (h)) * HTB)
#define PG8_SB(b, h) ((4 + (b) * 2 + (h)) * HTB)
#define PG8_STAGE(bufoff, gbase, voff) do { _Pragma("unroll") for (int _i = 0; _i < 2; ++_i) \
        __builtin_amdgcn_global_load_lds((const unsigned*)((const char*)(gbase) + (voff)[_i]), (PG8_LAS unsigned*)(lds + (bufoff) + ldsw + _i * 8192), 16, 0, 0); } while (0)
#define PG8_LDA(dst, b, h) do { _Pragma("unroll") for (int m = 0; m < 4; ++m) _Pragma("unroll") for (int k = 0; k < 2; ++k) dst[m][k] = *(const PG8_LAS bf16x8*)(lds + PG8_SA(b, h) + aoff + m * 2048 + k * 1024); } while (0)
#define PG8_LDB(dst, b, h) do { _Pragma("unroll") for (int n = 0; n < 2; ++n) _Pragma("unroll") for (int k = 0; k < 2; ++k) dst[n][k] = *(const PG8_LAS bf16x8*)(lds + PG8_SB(b, h) + boff + n * 2048 + k * 1024); } while (0)
#define PG8_MMA(ai, bj, At, Bt) do { __builtin_amdgcn_s_setprio(1); _Pragma("unroll") for (int m = 0; m < 4; ++m) _Pragma("unroll") for (int n = 0; n < 2; ++n) _Pragma("unroll") for (int k = 0; k < 2; ++k) \
        acc[ai][bj][m][n] = __builtin_amdgcn_mfma_f32_16x16x32_bf16(Bt[n][k], At[m][k], acc[ai][bj][m][n], 0, 0, 0); __builtin_amdgcn_s_setprio(0); } while (0)
#define PG8_WAIT_V(n) asm volatile("s_waitcnt vmcnt(" #n ")" ::: "memory")
#define PG8_WAIT_L(n) asm volatile("s_waitcnt lgkmcnt(" #n ")" ::: "memory")
#define PG8_BAR __builtin_amdgcn_s_barrier()
#define PG8_SCHED __builtin_amdgcn_sched_barrier(0)
    Unit cur, nxt; int ui = 0;
    if (!S.next(0, cur)) return;
    f32x4 acc[2][2][4][2];
#pragma unroll
    for (int a = 0; a < 2; ++a)
#pragma unroll
        for (int b = 0; b < 2; ++b)
#pragma unroll
            for (int m = 0; m < 4; ++m)
#pragma unroll
                for (int n = 0; n < 2; ++n) acc[a][b][m][n] = (f32x4){0.f, 0.f, 0.f, 0.f};
    bf16x8 At[4][2], B0[2][2], B1[2][2];
    const char* cA = (const char*)g.A + (size_t)cur.pm * tstep; const char* cB = (const char*)g.Bt + (size_t)cur.pn * tstep;
    S.a_ready(cur);
    if constexpr (SP2) {
        PG8_STAGE(PG8_SB(0, 0), cB, voffB); PG8_STAGE(PG8_SB(0, 1), cB + hstep, voffB); PG8_STAGE(PG8_SA(0, 0), cA, voffA); PG8_STAGE(PG8_SA(0, 1), cA + hstep, voffA);
        if (wr == 1) PG8_BAR;
        PG8_WAIT_V(2); PG8_BAR;
        PG8_STAGE(PG8_SB(1, 0), cB + kstep, voffB); PG8_STAGE(PG8_SA(1, 0), cA + kstep, voffA); PG8_STAGE(PG8_SB(1, 1), cB + hstep + kstep, voffB);
        PG8_WAIT_V(6); PG8_BAR;
    } else {
        PG8_STAGE(PG8_SB(0, 0), cB, voffB); PG8_STAGE(PG8_SA(0, 0), cA, voffA); PG8_STAGE(PG8_SB(0, 1), cB + hstep, voffB); PG8_STAGE(PG8_SA(0, 1), cA + hstep, voffA);
        if (wr == 1) PG8_BAR;
        PG8_WAIT_V(4); PG8_BAR;
        PG8_STAGE(PG8_SB(1, 0), cB + kstep, voffB); PG8_STAGE(PG8_SA(1, 0), cA + kstep, voffA); PG8_STAGE(PG8_SB(1, 1), cB + hstep + kstep, voffB);
        PG8_WAIT_V(6); PG8_BAR;
    }
    for (;;) {
        const bool has_next = S.next(ui + 1, nxt);
        const char* nA = has_next ? (const char*)g.A + (size_t)nxt.pm * tstep : cA; const char* nB = has_next ? (const char*)g.Bt + (size_t)nxt.pn * tstep : cB;
        for (int t = 0; t < nt; t += 2) {
            const bool last = (t == nt - 2);
            const char* a1 = cA + (size_t)(t + 1) * kstep;
            const char* a2 = last ? nA : cA + (size_t)(t + 2) * kstep; const char* b2 = last ? nB : cB + (size_t)(t + 2) * kstep;
            const char* a3 = a2 + kstep; const char* b3 = b2 + kstep;
            if (last && has_next) S.a_ready(nxt);
            if constexpr (SP2) {
            PG8_LDB(B0, 0, 0); PG8_LDB(B1, 0, 1); PG8_SCHED; PG8_LDA(At, 0, 0); PG8_STAGE(PG8_SA(1, 1), a1 + hstep, voffA);
            PG8_WAIT_V(8); PG8_WAIT_L(0); PG8_BAR; PG8_MMA(0, 0, At, B0); PG8_MMA(0, 1, At, B1); PG8_BAR; PG8_SCHED;
            PG8_LDA(At, 0, 1); PG8_STAGE(PG8_SB(0, 0), b2, voffB); PG8_STAGE(PG8_SB(0, 1), b2 + hstep, voffB); PG8_STAGE(PG8_SA(0, 0), a2, voffA);
            PG8_WAIT_V(8); PG8_WAIT_L(0); PG8_BAR; PG8_MMA(1, 0, At, B0); PG8_MMA(1, 1, At, B1); PG8_BAR; PG8_SCHED;
            PG8_LDB(B0, 1, 0); PG8_LDB(B1, 1, 1); PG8_SCHED; PG8_LDA(At, 1, 0); PG8_STAGE(PG8_SA(0, 1), a2 + hstep, voffA);
            PG8_WAIT_V(8); PG8_WAIT_L(0); PG8_BAR; PG8_MMA(0, 0, At, B0); PG8_MMA(0, 1, At, B1); PG8_BAR; PG8_SCHED;
            PG8_LDA(At, 1, 1); PG8_STAGE(PG8_SB(1, 0), b3, voffB); PG8_STAGE(PG8_SB(1, 1), b3 + hstep, voffB); PG8_STAGE(PG8_SA(1, 0), a3, voffA);
            PG8_WAIT_V(8); PG8_WAIT_L(0); PG8_BAR; PG8_MMA(1, 0, At, B0); PG8_MMA(1, 1, At, B1); PG8_BAR; PG8_SCHED;
            } else {
            PG8_LDB(B0, 0, 0); PG8_SCHED; PG8_LDA(At, 0, 0); PG8_STAGE(PG8_SA(1, 1), a1 + hstep, voffA);
            PG8_WAIT_L(8); PG8_BAR; PG8_WAIT_L(0); PG8_MMA(0, 0, At, B0); PG8_BAR; PG8_SCHED;
            PG8_LDB(B1, 0, 1); PG8_STAGE(PG8_SB(0, 0), b2, voffB);
            PG8_BAR; PG8_WAIT_L(0); PG8_MMA(0, 1, At, B1); PG8_BAR;
            PG8_LDA(At, 0, 1); PG8_STAGE(PG8_SA(0, 0), a2, voffA);
            PG8_BAR; PG8_WAIT_L(0); PG8_MMA(1, 0, At, B0); PG8_BAR; PG8_SCHED;
            PG8_STAGE(PG8_SB(0, 1), b2 + hstep, voffB);
            PG8_WAIT_V(6); PG8_BAR; PG8_MMA(1, 1, At, B1); PG8_BAR;
            PG8_LDB(B0, 1, 0); PG8_SCHED; PG8_LDA(At, 1, 0); PG8_STAGE(PG8_SA(0, 1), a2 + hstep, voffA);
            PG8_WAIT_L(8); PG8_BAR; PG8_WAIT_L(0); PG8_MMA(0, 0, At, B0); PG8_BAR; PG8_SCHED;
            PG8_LDB(B1, 1, 1); PG8_STAGE(PG8_SB(1, 0), b3, voffB);
            PG8_BAR; PG8_WAIT_L(0); PG8_MMA(0, 1, At, B1); PG8_BAR;
            PG8_LDA(At, 1, 1); PG8_STAGE(PG8_SA(1, 0), a3, voffA);
            PG8_BAR; PG8_WAIT_L(0); PG8_MMA(1, 0, At, B0); PG8_BAR; PG8_SCHED;
            PG8_STAGE(PG8_SB(1, 1), b3 + hstep, voffB);
            PG8_WAIT_V(6); PG8_BAR; PG8_MMA(1, 1, At, B1); PG8_BAR;
            }
        }
        if constexpr (ALIGN_EPI) { if (wr == 0) PG8_BAR; }
        if constexpr (!Epi::AFTER_DRAIN) { E(acc, cur, wr, wc, fr, fq); S.done(cur); }
        if (!has_next) break;
#pragma unroll
        for (int a = 0; a < 2; ++a)
#pragma unroll
            for (int b = 0; b < 2; ++b)
#pragma unroll
                for (int m = 0; m < 4; ++m)
#pragma unroll
                    for (int n = 0; n < 2; ++n) acc[a][b][m][n] = (f32x4){0.f, 0.f, 0.f, 0.f};
        cur = nxt; cA = nA; cB = nB; ++ui;
        if constexpr (ALIGN_EPI) { if (wr == 1) PG8_BAR; }
    }
    PG8_WAIT_V(0);
    if constexpr (!ALIGN_EPI) { if (wr == 0) PG8_BAR; }
    PG8_BAR;
    if constexpr (Epi::AFTER_DRAIN) { E.fused(acc, cur, wr, wc, fr, fq, lds, wid, lane); S.done(cur); }
#undef PG8_SA
#undef PG8_SB
#undef PG8_STAGE
#undef PG8_LDA
#undef PG8_LDB
#undef PG8_MMA
#undef PG8_WAIT_V
#undef PG8_WAIT_L
#undef PG8_BAR
#undef PG8_SCHED
}
}
#ifndef PG8_SP2
#define PG8_SP2 true
#endif
#include <hip/hip_bf16.h>
#include <cmath>
namespace attn_body {
using bf16=__hip_bfloat16;
using bf16x8=__attribute__((ext_vector_type(8)))short;
using s16x4=__attribute__((ext_vector_type(4)))short;
using f32x16=__attribute__((ext_vector_type(16)))float;
using u32x4=__attribute__((ext_vector_type(4)))unsigned;
constexpr int SEQ=4096,D=64,QP=512,KP=512,VP=512,OP=1024;
constexpr int NW=8,QBLK=32,QB=QBLK*NW,KVBLK=64,NQB=SEQ/QB;
constexpr int ATTN_UNIT_ROWS=QB;
__device__ __forceinline__ int crow(int r,int hi){return (r&3)+8*(r>>2)+4*hi;}
#define SBAR() __builtin_amdgcn_sched_barrier(0)
__device__ __forceinline__ void cmask(f32x16&p0,f32x16&p1,int jb,int qrel,int hi){
  const float NEG=-INFINITY; int kb=64*jb+4*hi;
  #pragma unroll
  for(int r=0;r<16;++r){int kv=kb+(r&3)+8*(r>>2); if(kv>qrel)p0[r]=NEG; if(kv+32>qrel)p1[r]=NEG;}
}

constexpr int NSLOT=3, SLOTB=8192;
constexpr int LDS_K=0, LDS_V=NSLOT*SLOTB, LDS_WS=2*NSLOT*SLOTB, LDS_OST=LDS_WS+NW*64*4, LDS_BYTES=LDS_OST+NW*4096;
constexpr float C2=0.125f*1.4426950408889634f;
__device__ __forceinline__ void glds16(const void*gsrc,unsigned lds_dst){unsigned keep;
  asm volatile("s_mov_b32 %0, m0\n\ts_mov_b32 m0, %2\n\ts_nop 0\n\tglobal_load_lds_dwordx4 %1, off\n\ts_mov_b32 m0, %0":"=&s"(keep):"v"(gsrc),"s"(lds_dst):"memory");}
__device__ __forceinline__ float max3f(float a,float b,float c){float r;asm("v_max3_f32 %0, %1, %2, %3":"=v"(r):"v"(a),"v"(b),"v"(c));return r;}
__device__ __forceinline__ float max2f(float a,float b){float r;asm("v_max_f32_e32 %0, %1, %2":"=v"(r):"v"(a),"v"(b));return r;}
__device__ __forceinline__ float fadd_s(float a,float b){float r;asm("v_add_f32_e32 %0, %1, %2":"=v"(r):"v"(a),"v"(b));return r;}
__device__ __forceinline__ float fsub_s(float a,float b){float r;asm("v_sub_f32_e32 %0, %1, %2":"=v"(r):"v"(a),"v"(b));return r;}
typedef float f32x2_t __attribute__((ext_vector_type(2))); typedef __bf16 bf16x2_t __attribute__((ext_vector_type(2)));
__device__ __forceinline__ unsigned cvtpk_s(float lo,float hi){f32x2_t v={lo,hi};bf16x2_t b=__builtin_convertvector(v,bf16x2_t);return __builtin_bit_cast(unsigned,b);}
#define WAIT_BAR(N) asm volatile("s_waitcnt vmcnt(" #N ") lgkmcnt(0)\n\ts_barrier":::"memory")

__device__ __forceinline__ void qkt(f32x16&p0,f32x16&p1,const char*Kslot,const bf16x8*qr,const f32x16&negm,int r32,int hi){
  const char*kb=Kslot+hi*1024+r32*16;
  #pragma unroll
  for(int d0=0;d0<4;++d0){
    const bf16x8 b0=*reinterpret_cast<const bf16x8*>(kb+d0*2048);
    const bf16x8 b1=*reinterpret_cast<const bf16x8*>(kb+d0*2048+512);
    if(d0==0){p0=__builtin_amdgcn_mfma_f32_32x32x16_bf16(b0,qr[0],negm,0,0,0);p1=__builtin_amdgcn_mfma_f32_32x32x16_bf16(b1,qr[0],negm,0,0,0);}
    else{p0=__builtin_amdgcn_mfma_f32_32x32x16_bf16(b0,qr[d0],p0,0,0,0);p1=__builtin_amdgcn_mfma_f32_32x32x16_bf16(b1,qr[d0],p1,0,0,0);}}
}
typedef __attribute__((address_space(3))) const char* lds_cptr;
typedef short v4i16_t __attribute__((ext_vector_type(4)));
__device__ __forceinline__ void kload8(bf16x8*kf,lds_cptr kp){
  kf[0]=*(const __attribute__((address_space(3))) bf16x8*)(kp);      kf[1]=*(const __attribute__((address_space(3))) bf16x8*)(kp+512);
  kf[2]=*(const __attribute__((address_space(3))) bf16x8*)(kp+2048); kf[3]=*(const __attribute__((address_space(3))) bf16x8*)(kp+2560);
  kf[4]=*(const __attribute__((address_space(3))) bf16x8*)(kp+4096); kf[5]=*(const __attribute__((address_space(3))) bf16x8*)(kp+4608);
  kf[6]=*(const __attribute__((address_space(3))) bf16x8*)(kp+6144); kf[7]=*(const __attribute__((address_space(3))) bf16x8*)(kp+6656);
}
__device__ __forceinline__ void kload2(bf16x8*kf,lds_cptr kp,int j){ kf[2*j]=*(const __attribute__((address_space(3))) bf16x8*)(kp+j*2048); kf[2*j+1]=*(const __attribute__((address_space(3))) bf16x8*)(kp+j*2048+512); }
__device__ __forceinline__ s16x4 vtr(lds_cptr p){ return __builtin_bit_cast(s16x4,__builtin_amdgcn_ds_read_tr16_b64_v4i16((__attribute__((address_space(3))) v4i16_t*)p)); }
__device__ __forceinline__ float rowmax(const f32x16&p0,const f32x16&p1){
  float a=max3f(p0[0],p0[1],p1[0]),b=max3f(p0[2],p0[3],p1[1]);a=max3f(a,p1[2],p1[3]);
  #pragma unroll
  for(int r=4;r<16;r+=4){a=max3f(a,p0[r],p0[r+1]);b=max3f(b,p0[r+2],p0[r+3]);a=max3f(a,p1[r],p1[r+1]);b=max3f(b,p1[r+2],p1[r+3]);}
  const float m=max2f(a,b);
  auto rr=__builtin_amdgcn_permlane32_swap(__float_as_uint(m),__float_as_uint(m),false,false);
  return max2f(__uint_as_float(rr[0]),__uint_as_float(rr[1]));
}
__device__ __forceinline__ void pv(f32x16*o,int vb,bf16x8 pa0,bf16x8 pa1,bf16x8 pa2,bf16x8 pa3){
  #pragma unroll
  for(int d0=0;d0<2;++d0){s16x4 lo[4],hi[4];
    #pragma unroll
    for(int ks=0;ks<4;++ks){
      asm volatile("ds_read_b64_tr_b16 %0,%1 offset:%c2":"=&v"(lo[ks]):"v"(vb),"i"(d0*4096+ks*1024):"memory");
      asm volatile("ds_read_b64_tr_b16 %0,%1 offset:%c2":"=&v"(hi[ks]):"v"(vb),"i"(d0*4096+ks*1024+512):"memory");}
    asm volatile("s_waitcnt lgkmcnt(0)":::"memory");SBAR();
    #define PK(k) (bf16x8){lo[k][0],lo[k][1],lo[k][2],lo[k][3],hi[k][0],hi[k][1],hi[k][2],hi[k][3]}
    o[d0]=__builtin_amdgcn_mfma_f32_32x32x16_bf16(pa0,PK(0),o[d0],0,0,0);
    o[d0]=__builtin_amdgcn_mfma_f32_32x32x16_bf16(pa1,PK(1),o[d0],0,0,0);
    o[d0]=__builtin_amdgcn_mfma_f32_32x32x16_bf16(pa2,PK(2),o[d0],0,0,0);
    o[d0]=__builtin_amdgcn_mfma_f32_32x32x16_bf16(pa3,PK(3),o[d0],0,0,0);
    #undef PK
  }
}

#ifndef ATTN_STORE16
#define ATTN_STORE16(p,v) (*(u32x4*)(p)=(v))
#endif
template<int THRL> __device__ __forceinline__ void attn_unit(int qb,const bf16*Q,const bf16*__restrict__ K,const bf16*__restrict__ V,bf16*O,char*shm){
  int tid_=threadIdx.x; asm volatile("":"+v"(tid_));
  const int tid=tid_,lane=tid&63,r32=lane&31,hi=lane>>5; const int wid=__builtin_amdgcn_readfirstlane(tid>>6);
  const int q0=qb*QB;
  const bf16*Qw=Q+(long)(q0+wid*QBLK)*QP;
  const bf16*Kh=K,*Vh=V;
  const unsigned lds0=(unsigned)(uintptr_t)shm;
  float*wsf=(float*)(shm+LDS_WS)+wid*64;
  const bf16*ksrc=Kh+(long)lane*KP+wid*8;
  const bf16*vsrc=Vh+(long)(16*(wid&3)+(lane>>2))*VP+(wid>>2)*32+(lane&3)*8;
  const unsigned kdst=lds0+LDS_K+wid*1024, vdst=lds0+LDS_V+wid*1024;
  #define DMA_K(t,slot) glds16(ksrc+(long)(t)*KVBLK*KP,(unsigned)__builtin_amdgcn_readfirstlane(kdst+(slot)))
  #define DMA_V(t,slot) glds16(vsrc+(long)(t)*KVBLK*VP,(unsigned)__builtin_amdgcn_readfirstlane(vdst+(slot)))
  const int vb0=(int)(lds0+LDS_V)+((lane>>4)&1)*32+(lane&3)*8+(4*hi+((lane&15)>>2))*64;
  const char*Kbase=shm+LDS_K; bf16x8 kf[8];
  const lds_cptr shm3=(lds_cptr)shm; const lds_cptr kp0=shm3+LDS_K+hi*1024+r32*16; const lds_cptr vp0=shm3+LDS_V+((lane>>4)&1)*32+(lane&3)*8+(4*hi+((lane&15)>>2))*64;
  const int NT=(q0+QB)/KVBLK;
  DMA_K(0,0);DMA_V(0,0);DMA_K(1,SLOTB);
  bf16x8 qr[4];
  #pragma unroll
  for(int d0=0;d0<4;++d0)qr[d0]=*reinterpret_cast<const bf16x8*>(&Qw[(long)r32*QP+d0*16+hi*8]);
  float mhat=0.f,l_reg=0.f;f32x16 o[2];o[0]=f32x16{};o[1]=f32x16{};f32x16 negm=f32x16{};asm volatile("":"+v"(negm));
  const int qrel=wid*QBLK+r32;
  #define CMASK(P0,P1,t) do{int jb_=(t)-(NT-4); if(jb_>=0)cmask(P0,P1,jb_,qrel,hi);}while(0)
  bool resc=false;
  #define START(P0,P1) do{ const float rm=rowmax(P0,P1); resc=false; \
    { const float dl=rm; mhat=fadd_s(mhat,dl); \
      _Pragma("unroll") for(int r=0;r<16;++r){P0[r]=fsub_s(P0[r],dl);P1[r]=fsub_s(P1[r],dl);} \
      _Pragma("unroll") for(int r=0;r<16;++r)negm[r]=-mhat; asm volatile("":"+v"(negm)); } \
    _Pragma("unroll") for(int r=0;r<16;++r)P0[r]=__builtin_amdgcn_exp2f(P0[r]); }while(0)
  #define RESC() do{ if(resc){ asm volatile("s_waitcnt lgkmcnt(0)":::"memory"); \
      _Pragma("unroll") for(int d_=0;d_<2;++d_) _Pragma("unroll") for(int r=0;r<16;++r)o[d_][r]*=wsf[crow(r,hi)]; } }while(0)
  f32x16 pA0,pA1,pB0,pB1;
  int sl_prev=0,sl_cur=0,sl_next=SLOTB;
  #define ROT() do{sl_prev=sl_cur;sl_cur=sl_next;sl_next=(sl_next==(NSLOT-1)*SLOTB)?0:sl_next+SLOTB;}while(0)
  DMA_K(2,2*SLOTB);
  WAIT_BAR(3);
  qkt(pA0,pA1,Kbase,qr,negm,r32,hi);asm volatile("s_nop 15\n\ts_nop 7":"+v"(pA0),"+v"(pA1));CMASK(pA0,pA1,0);
  START(pA0,pA1);
  _Pragma("unroll") for(int r=0;r<16;++r)pA1[r]=__builtin_amdgcn_exp2f(pA1[r]);
  WAIT_BAR(0);
  DMA_K(3,0);DMA_V(1,SLOTB);
  ROT();
  kload8(kf,kp0+sl_cur);
  WAIT_BAR(2);
  s16x4 vlo[8],vhi[8]; u32x4 pw0,pw1,pw2,pw3;
  #define PKW(P,B) cvtpk_s(P[B],P[B+1])
  #define PAF(k) __builtin_bit_cast(bf16x8,pw##k)
  #define VFR(i) (bf16x8){vlo[i][0],vlo[i][1],vlo[i][2],vlo[i][3],vhi[i][0],vhi[i][1],vhi[i][2],vhi[i][3]}
  #define PIN(x) asm volatile("":"+v"(x))
  #define MX3(a,b,c) __builtin_fmaxf(__builtin_fmaxf((a),(b)),(c))
  #define GAPA(MF,A0,A1,A2,A3,W0,W1,PW) do{ MF; sacc+=A0; sacc+=A1; sacc+=A2; sacc+=A3; PIN(sacc); W0; W1; PIN(PW); SBAR(); }while(0)
  #define EX(v) __builtin_amdgcn_exp2f(v)
  #define GAPB(MF,X,B) do{ MF; X[B]=EX(X[B]); X[B+1]=EX(X[B+1]); X[B+2]=EX(X[B+2]); X[B+3]=EX(X[B+3]); PIN(X); SBAR(); }while(0)
  #define VRD(i) do{ vlo[i]=vtr(vp_+(((i)>>2)*4096+((i)&3)*1024)); vhi[i]=vtr(vp_+(((i)>>2)*4096+((i)&3)*1024+512)); }while(0)
  #define KRD(G,j) do{ if(G){ kload2(kf,kp0+sl_next,j); SBAR(); } }while(0)
  #define STEP(C0,C1,P0,P1,t,GK,GV,GL) do{ SBAR(); \
    const lds_cptr vp_=vp0+sl_prev; \
    VRD(0); SBAR(); float sacc=(P0[0]+P0[1]); \
    GAPA(C0=__builtin_amdgcn_mfma_f32_32x32x16_bf16(kf[0],qr[0],negm,0,0,0), P0[2],P0[3],P0[4],P0[5],     pw0[0]=PKW(P0,0), pw0[1]=PKW(P0,2), pw0); \
    VRD(4); SBAR(); GAPA(C1=__builtin_amdgcn_mfma_f32_32x32x16_bf16(kf[1],qr[0],negm,0,0,0), P0[6],P0[7],P0[8],P0[9],     pw0[2]=PKW(P0,4), pw0[3]=PKW(P0,6), pw0); \
    VRD(1); SBAR(); GAPA(C0=__builtin_amdgcn_mfma_f32_32x32x16_bf16(kf[2],qr[1],C0,0,0,0),   P0[10],P0[11],P0[12],P0[13], pw1[0]=PKW(P0,8), pw1[1]=PKW(P0,10), pw1); \
    VRD(5); SBAR(); GAPA(C1=__builtin_amdgcn_mfma_f32_32x32x16_bf16(kf[3],qr[1],C1,0,0,0),   P0[14],P0[15],P1[0],P1[1],   pw1[2]=PKW(P0,12),pw1[3]=PKW(P0,14), pw1); \
    VRD(2); SBAR(); GAPA(C0=__builtin_amdgcn_mfma_f32_32x32x16_bf16(kf[4],qr[2],C0,0,0,0),   P1[2],P1[3],P1[4],P1[5],     pw2[0]=PKW(P1,0), pw2[1]=PKW(P1,2), pw2); \
    VRD(6); SBAR(); GAPA(C1=__builtin_amdgcn_mfma_f32_32x32x16_bf16(kf[5],qr[2],C1,0,0,0),   P1[6],P1[7],P1[8],P1[9],     pw2[2]=PKW(P1,4), pw2[3]=PKW(P1,6), pw2); \
    VRD(3); SBAR(); GAPA(C0=__builtin_amdgcn_mfma_f32_32x32x16_bf16(kf[6],qr[3],C0,0,0,0),   P1[10],P1[11],P1[12],P1[13], pw3[0]=PKW(P1,8), pw3[1]=PKW(P1,10), pw3); \
    VRD(7); SBAR(); GAPA(C1=__builtin_amdgcn_mfma_f32_32x32x16_bf16(kf[7],qr[3],C1,0,0,0),   P1[14],P1[15],0.f,0.f,       pw3[2]=PKW(P1,12),pw3[3]=PKW(P1,14), pw3); \
    l_reg+=sacc; \
    if(GK){DMA_K((t)+3,sl_cur);} if(GV){DMA_V((t)+1,sl_next);} \
    CMASK(C0,C1,t); \
    { float a=MX3(C0[0],C0[1],C1[0]),b=MX3(C0[2],C0[3],C1[1]); a=MX3(a,C1[2],C1[3]); \
      _Pragma("unroll") for(int r=4;r<16;r+=4){a=MX3(a,C0[r],C0[r+1]);b=MX3(b,C0[r+2],C0[r+3]);a=MX3(a,C1[r],C1[r+1]);b=MX3(b,C1[r+2],C1[r+3]);} \
      float rm=__builtin_fmaxf(a,b); { auto rr=__builtin_amdgcn_permlane32_swap(__float_as_uint(rm),__float_as_uint(rm),false,false); rm=__builtin_fmaxf(__uint_as_float(rr[0]),__uint_as_float(rr[1])); } \
      resc=false; \
      if(__builtin_expect(__any(rm>(float)THRL),0)){ const float dl=__builtin_fmaxf(rm,0.f); mhat+=dl; \
        _Pragma("unroll") for(int r=0;r<16;++r){C0[r]-=dl;C1[r]-=dl;} \
        _Pragma("unroll") for(int r=0;r<16;++r)negm[r]=-mhat; asm volatile("":"+v"(negm)); \
        const float f=__builtin_amdgcn_exp2f(-dl); l_reg*=f; if(hi==0)wsf[r32]=f; resc=true; } } \
    SBAR(); \
    GAPB(o[0]=__builtin_amdgcn_mfma_f32_32x32x16_bf16(PAF(0),VFR(0),o[0],0,0,0), C0,0); \
    GAPB(o[1]=__builtin_amdgcn_mfma_f32_32x32x16_bf16(PAF(0),VFR(4),o[1],0,0,0), C0,4); \
    KRD(GL,0); GAPB(o[0]=__builtin_amdgcn_mfma_f32_32x32x16_bf16(PAF(1),VFR(1),o[0],0,0,0), C0,8); \
    KRD(GL,1); GAPB(o[1]=__builtin_amdgcn_mfma_f32_32x32x16_bf16(PAF(1),VFR(5),o[1],0,0,0), C0,12); \
    KRD(GL,2); GAPB(o[0]=__builtin_amdgcn_mfma_f32_32x32x16_bf16(PAF(2),VFR(2),o[0],0,0,0), C1,0); \
    KRD(GL,3); GAPB(o[1]=__builtin_amdgcn_mfma_f32_32x32x16_bf16(PAF(2),VFR(6),o[1],0,0,0), C1,4); \
    GAPB(o[0]=__builtin_amdgcn_mfma_f32_32x32x16_bf16(PAF(3),VFR(3),o[0],0,0,0), C1,8); \
    GAPB(o[1]=__builtin_amdgcn_mfma_f32_32x32x16_bf16(PAF(3),VFR(7),o[1],0,0,0), C1,12); \
    }while(0)
  int t=1;
  #undef CMASK
  #define CMASK(P0,P1,t) do{}while(0)
  for(;t+5<NT;t+=2){
    STEP(pB0,pB1,pA0,pA1,t,true,true,true);     WAIT_BAR(2); RESC(); ROT();
    STEP(pA0,pA1,pB0,pB1,t+1,true,true,true);   WAIT_BAR(2); RESC(); ROT();
  }
  #undef CMASK
  #define CMASK(P0,P1,t) do{int jb_=(t)-(NT-4); if(jb_>=0)cmask(P0,P1,jb_,qrel,hi);}while(0)
  #define ENDW(tt) do{ if((tt)+3<NT){WAIT_BAR(2);} else if((tt)+2<NT){WAIT_BAR(1);} else {WAIT_BAR(0);} }while(0)
  for(;t+1<NT;t+=2){
    STEP(pB0,pB1,pA0,pA1,t,(t+3<NT),(t+1<NT),(t+1<NT));       ENDW(t);   RESC(); ROT();
    STEP(pA0,pA1,pB0,pB1,t+1,(t+4<NT),(t+2<NT),(t+2<NT));     ENDW(t+1); RESC(); ROT();
  }
  STEP(pB0,pB1,pA0,pA1,NT-1,false,false,false); RESC();
  { float sacc=pB0[0]+pB0[1]; _Pragma("unroll") for(int r=2;r<16;++r)sacc+=pB0[r]; _Pragma("unroll") for(int r=0;r<16;++r)sacc+=pB1[r]; l_reg+=sacc;
    pw0=(u32x4){PKW(pB0,0),PKW(pB0,2),PKW(pB0,4),PKW(pB0,6)};pw1=(u32x4){PKW(pB0,8),PKW(pB0,10),PKW(pB0,12),PKW(pB0,14)};pw2=(u32x4){PKW(pB1,0),PKW(pB1,2),PKW(pB1,4),PKW(pB1,6)};pw3=(u32x4){PKW(pB1,8),PKW(pB1,10),PKW(pB1,12),PKW(pB1,14)};
    SBAR(); pv(o,vb0+sl_cur,PAF(0),PAF(1),PAF(2),PAF(3)); }
  #undef PKW
  #undef PAF
  #undef VFR
  #undef PIN
  #undef MX3
  #undef GAPA
  #undef GAPB
  #undef EX
  #undef VRD
  #undef KRD
  #undef STEP
  #undef ENDW
  {auto rr=__builtin_amdgcn_permlane32_swap(__float_as_uint(l_reg),__float_as_uint(l_reg),false,false);l_reg=__uint_as_float(rr[0])+__uint_as_float(rr[1]);}
  if(hi==0)wsf[32+r32]=l_reg;asm volatile("s_waitcnt lgkmcnt(0)":::"memory");
  float rli[16];
  #pragma unroll
  for(int r=0;r<16;++r)rli[r]=__builtin_amdgcn_rcpf(wsf[32+crow(r,hi)]);
  bf16*Ow=O+(long)(q0+wid*QBLK)*OP;
  { bf16*stg=(bf16*)(shm+LDS_OST)+wid*2048;
    #pragma unroll
    for(int r=0;r<16;++r){const int orow=crow(r,hi);
      #pragma unroll
      for(int d0=0;d0<2;++d0)stg[orow*64+d0*32+r32]=__float2bfloat16(o[d0][r]*rli[r]);}
    asm volatile("s_waitcnt lgkmcnt(0)":::"memory");
    #pragma unroll
    for(int i=0;i<4;++i){const int row=i*8+(lane>>3),ch=lane&7; const u32x4 v=*(const u32x4*)(stg+row*64+ch*8); ATTN_STORE16(Ow+(long)row*OP+ch*8,v);} }
  asm volatile("s_waitcnt lgkmcnt(0)\n\ts_barrier":::"memory");
  #undef DMA_K
  #undef DMA_V
  #undef CMASK
  #undef START
  #undef RESC
  #undef ROT
}
constexpr int ATTN_LDS_BYTES=LDS_BYTES;
#undef SBAR
#undef WAIT_BAR
}
namespace swa128 {
constexpr int D = 128, QS = 512, OS = 1024;
constexpr float THR = 8.f; constexpr bool WSKIP = false;
constexpr float SCALE = 0.08838834764831845f;
constexpr int NW = 8, QBLK = 32, KVBLK = 64, QB = NW * QBLK;
constexpr int SHM_V = KVBLK * D * 2, SHM_K = KVBLK * D * 2;
constexpr int LDS_BYTES = 2 * SHM_V + 2 * SHM_K + NW * 64 * 4;

using bf16 = __hip_bfloat16;
typedef short bf16x8 __attribute__((ext_vector_type(8)));
typedef short s16x4 __attribute__((ext_vector_type(4)));
typedef float f32x16 __attribute__((ext_vector_type(16)));
typedef float f32x4 __attribute__((ext_vector_type(4)));
typedef unsigned u32x4 __attribute__((ext_vector_type(4)));
template <class A, class Bt> struct same_t { static constexpr bool v = false; };
template <class A> struct same_t<A, A> { static constexpr bool v = true; };

#define KSWZ(row, colB) ((row) * 256 + ((colB) ^ (((row) & 7) << 4)))
#define SBAR() __builtin_amdgcn_sched_barrier(0)
__device__ __forceinline__ int v_st(int k, int c) { const int kk = (k & ~0xC) | ((k & 4) << 1) | ((k & 8) >> 1); return ((kk >> 3) * 4 + (c >> 5)) * 512 + ((kk & 7) * 32 + (c & 31)) * 2; }
__device__ __forceinline__ int v_rd_base(int lane) { return ((lane & 3) << 3) | (((lane >> 2) & 3) << 6) | (((lane >> 4) & 1) << 5) | (((lane >> 5) & 1) << 8); }
constexpr int v_rd_off(int d0, int ks, int half) { return d0 * 512 + ks * 4096 + half * 2048; }
__device__ __forceinline__ int crow(int r, int hi) { return (r & 3) + 8 * (r >> 2) + 4 * hi; }
__device__ __forceinline__ unsigned cvtpk(float lo, float hi) {
    unsigned r; asm volatile("v_cvt_pk_bf16_f32 %0, %1, %2" : "=v"(r) : "v"(lo), "v"(hi)); return r;
}
__device__ __forceinline__ bf16x8 pack8(f32x4 a, f32x4 b) {
    u32x4 w = {cvtpk(a[0], a[1]), cvtpk(a[2], a[3]), cvtpk(b[0], b[1]), cvtpk(b[2], b[3])};
    return *reinterpret_cast<bf16x8*>(&w);
}
template <class T> __device__ __forceinline__ bf16x8 load8(const T* p) {
    if constexpr (same_t<T, float>::v) { return pack8(*(const f32x4*)p, *(const f32x4*)(p + 4)); }
    else { return *reinterpret_cast<const bf16x8*>(p); }
}
__device__ __forceinline__ void mask_tile(f32x16& p0, f32x16& p1, int dq, unsigned W) {
    const float NEG = -__builtin_inff();
#pragma unroll
    for (int r = 0; r < 16; ++r) {
        const int c = (r & 3) + 8 * (r >> 2);
        if ((unsigned)(dq - c) >= W) p0[r] = NEG;
        if ((unsigned)(dq - c - 32) >= W) p1[r] = NEG;
    }
}
__device__ __forceinline__ void sel_tile(f32x16& p0, f32x16& p1, unsigned long long w, int hi) {
    const unsigned NEGB = 0xff800000u; const unsigned lo = (unsigned)w >> (4 * hi), hw = (unsigned)(w >> 32) >> (4 * hi);
#pragma unroll
    for (int r = 0; r < 16; ++r) {
        const int c = (r & 3) + 8 * (r >> 2);
        const unsigned x0 = (unsigned)__builtin_amdgcn_sbfe((int)lo, c, 1), x1 = (unsigned)__builtin_amdgcn_sbfe((int)hw, c, 1);
        p0[r] = __uint_as_float((x0 & __float_as_uint(p0[r])) | (~x0 & NEGB));
        p1[r] = __uint_as_float((x1 & __float_as_uint(p1[r])) | (~x1 & NEGB));
    }
}
__device__ __forceinline__ void partialSM(f32x16& p0, f32x16& p1, float& m_reg, float& mn, float& alpha) {
    float pmax = p0[0]; for (int r = 1; r < 16; ++r) pmax = fmaxf(pmax, p0[r]); for (int r = 0; r < 16; ++r) pmax = fmaxf(pmax, p1[r]);
    { auto rr = __builtin_amdgcn_permlane32_swap(__float_as_uint(pmax), __float_as_uint(pmax), false, false);
      pmax = fmaxf(__uint_as_float(rr[0]), __uint_as_float(rr[1])); }
    constexpr float C2 = 1.4426950408889634f * SCALE;
    if (__builtin_expect(__all((pmax - m_reg) * SCALE <= THR), 1)) { mn = m_reg; alpha = 1.f; }
    else { mn = fmaxf(m_reg, pmax); alpha = __builtin_amdgcn_exp2f((m_reg - mn) * C2); m_reg = mn; }
    const float mnL = -mn * C2;
    for (int r = 0; r < 16; ++r) p0[r] = fmaf(p0[r], C2, mnL); for (int r = 0; r < 16; ++r) p1[r] = fmaf(p1[r], C2, mnL);
    for (int r = 0; r < 16; ++r) p0[r] = __builtin_amdgcn_exp2f(p0[r]);
}
__device__ __forceinline__ void finishSM(f32x16& p0, f32x16& p1, float alpha, float& l_reg, bf16x8& pa0, bf16x8& pa1, bf16x8& pa2, bf16x8& pa3) {
    for (int r = 0; r < 16; ++r) p1[r] = __builtin_amdgcn_exp2f(p1[r]);
    float ps = 0; for (int r = 0; r < 16; ++r) ps += p0[r]; for (int r = 0; r < 16; ++r) ps += p1[r];
    { auto rr = __builtin_amdgcn_permlane32_swap(__float_as_uint(ps), __float_as_uint(ps), false, false);
      ps = __uint_as_float(rr[0]) + __uint_as_float(rr[1]); }
    l_reg = l_reg * alpha + ps;
#define PK4(P, B_, OUT) do { unsigned a0 = cvtpk(P[B_+0], P[B_+1]), a1 = cvtpk(P[B_+2], P[B_+3]);                          \
        unsigned b0 = cvtpk(P[B_+4], P[B_+5]), b1 = cvtpk(P[B_+6], P[B_+7]);                                             \
        auto r0 = __builtin_amdgcn_permlane32_swap(a0, b0, false, false); auto r1 = __builtin_amdgcn_permlane32_swap(a1, b1, false, false); \
        u32x4 w = {r0[0], r1[0], r0[1], r1[1]}; OUT = *reinterpret_cast<bf16x8*>(&w); } while (0)
    PK4(p0, 0, pa0); PK4(p0, 8, pa1); PK4(p1, 0, pa2); PK4(p1, 8, pa3);
#undef PK4
}
template <int KB, bool SK>
__device__ __forceinline__ void qkt(f32x16& p0, f32x16& p1, const char* K_lds, int r32, int hi, const bf16x8* qr, bool act) {
    if (SK && !act) { const float NEG = -__builtin_inff();
#pragma unroll
        for (int r = 0; r < 16; ++r) { p0[r] = NEG; p1[r] = NEG; } return; }
    p0 = f32x16{}; p1 = f32x16{};
    const char* kb[4];
#pragma unroll
    for (int dd = 0; dd < 4; ++dd) kb[dd] = K_lds + KB * SHM_K + KSWZ(r32, (dd * 16 + hi * 8) * 2);
#pragma unroll
    for (int d0 = 0; d0 < 8; ++d0) { const char* a = kb[d0 & 3] + (d0 >> 2) * 128;
        bf16x8 b0 = *reinterpret_cast<const bf16x8*>(a);
        bf16x8 b1 = *reinterpret_cast<const bf16x8*>(a + 32 * 256);
        p0 = __builtin_amdgcn_mfma_f32_32x32x16_bf16(b0, qr[d0], p0, 0, 0, 0);
        p1 = __builtin_amdgcn_mfma_f32_32x32x16_bf16(b1, qr[d0], p1, 0, 0, 0); }
}
template <int VB, bool SK>
__device__ __forceinline__ void pv_tile(f32x16* o, int vb0, bf16x8 pa0, bf16x8 pa1, bf16x8 pa2, bf16x8 pa3, bool act) {
    if (SK && !act) return;
#define TRRD(dst, off) asm volatile("ds_read_b64_tr_b16 %0, %1 offset:%2" : "=&v"(dst) : "v"(vb0), "i"(off) : "memory")
#define PV_D0(d0) do { s16x4 l0, l1, l2, l3, h0, h1, h2, h3; constexpr int b_ = VB * SHM_V + v_rd_off(d0, 0, 0);     \
        TRRD(l0, b_); TRRD(h0, b_ + 2048); TRRD(l1, b_ + 4096); TRRD(h1, b_ + 6144); TRRD(l2, b_ + 8192); TRRD(h2, b_ + 10240); TRRD(l3, b_ + 12288); TRRD(h3, b_ + 14336); \
        asm volatile("s_waitcnt lgkmcnt(0)" ::: "memory"); SBAR();                 \
        o[d0] = __builtin_amdgcn_mfma_f32_32x32x16_bf16(pa0, (bf16x8){l0[0], l0[1], l0[2], l0[3], h0[0], h0[1], h0[2], h0[3]}, o[d0], 0, 0, 0);   \
        o[d0] = __builtin_amdgcn_mfma_f32_32x32x16_bf16(pa1, (bf16x8){l1[0], l1[1], l1[2], l1[3], h1[0], h1[1], h1[2], h1[3]}, o[d0], 0, 0, 0);   \
        o[d0] = __builtin_amdgcn_mfma_f32_32x32x16_bf16(pa2, (bf16x8){l2[0], l2[1], l2[2], l2[3], h2[0], h2[1], h2[2], h2[3]}, o[d0], 0, 0, 0);   \
        o[d0] = __builtin_amdgcn_mfma_f32_32x32x16_bf16(pa3, (bf16x8){l3[0], l3[1], l3[2], l3[3], h3[0], h3[1], h3[2], h3[3]}, o[d0], 0, 0, 0); } while (0)
    PV_D0(0); PV_D0(1); PV_D0(2); PV_D0(3);
#undef PV_D0
#undef TRRD
}

template <class TIn, class TOut> struct BlockRef { const TIn* Q; const TIn* K; const TIn* V; TOut* O; int P0; const unsigned long long* MW; };
template <class TIn> struct Seam {
    bf16x8 qr[8];
    bf16x8 st_v0, st_v1, st_k0, st_k1; f32x4 sf0, sf1, sf2, sf3;
    f32x4 tq[16];
};
__device__ __forceinline__ int swa_jlo(int P0, int W) { const int lowk = P0 - W + 1; return lowk > 0 ? lowk / KVBLK : 0; }
#define ROW(p, k0, rr) ((p) + (size_t)((k0) + (rr)) * D + sc)
#define VMW() asm volatile("s_waitcnt vmcnt(0)" ::: "memory")
#define VMWN(n) asm volatile("s_waitcnt vmcnt(%0)" :: "i"(n) : "memory")
#define SLOAD_H(Kp, Vp, k0) do { S.st_v0 = load8<TIn>(ROW(Vp, k0, sr)); S.st_v1 = load8<TIn>(ROW(Vp, k0, 32 + sr));              \
                         S.st_k0 = load8<TIn>(ROW(Kp, k0, sr)); S.st_k1 = load8<TIn>(ROW(Kp, k0, 32 + sr)); } while (0)
#define SWRITE_HK(bf) do { *(bf16x8*)(K_lds + (bf) * SHM_K + kws) = S.st_k0; *(bf16x8*)(K_lds + (bf) * SHM_K + kws + 32 * 256) = S.st_k1; } while (0)
#define SWRITE_HV(bf) do { *(bf16x8*)(V_lds + (bf) * SHM_V + vst0) = S.st_v0; *(bf16x8*)(V_lds + (bf) * SHM_V + vst1) = S.st_v1; } while (0)
#define SWRITE_H(bf) do { SWRITE_HV(bf); SWRITE_HK(bf); } while (0)
#define SLOAD_F(p, k0) do { S.sf0 = *(const f32x4*)ROW(p, k0, sr); S.sf1 = *(const f32x4*)(ROW(p, k0, sr) + 4);                \
                            S.sf2 = *(const f32x4*)ROW(p, k0, 32 + sr); S.sf3 = *(const f32x4*)(ROW(p, k0, 32 + sr) + 4); } while (0)
#define SWRITE_KF(bf) do { *(bf16x8*)(K_lds + (bf) * SHM_K + kws) = pack8(S.sf0, S.sf1); *(bf16x8*)(K_lds + (bf) * SHM_K + kws + 32 * 256) = pack8(S.sf2, S.sf3); } while (0)
#define SWRITE_VF(bf) do { *(bf16x8*)(V_lds + (bf) * SHM_V + vst0) = pack8(S.sf0, S.sf1); *(bf16x8*)(V_lds + (bf) * SHM_V + vst1) = pack8(S.sf2, S.sf3); } while (0)
template <class TIn, class TOut>
__device__ __forceinline__ void causal_swa_prime(const BlockRef<TIn, TOut>& cur, int W, char* lds, Seam<TIn>& S) {
    constexpr bool F32 = same_t<TIn, float>::v;
    const int tid = threadIdx.x, wid = __builtin_amdgcn_readfirstlane(tid >> 6), lane = tid & 63, r32 = lane & 31, hi = lane >> 5;
    const int sr = tid >> 4, sc = (tid & 15) * 8, kws = KSWZ(sr, sc * 2); char* K_lds = lds + 2 * SHM_V;
    const int kb0 = swa_jlo(cur.P0, W) * KVBLK;
    for (int d0 = 0; d0 < 8; ++d0) S.qr[d0] = load8<TIn>(cur.Q + (size_t)(wid * QBLK + r32) * QS + d0 * 16 + hi * 8);
    if constexpr (F32) { SLOAD_F((const float*)cur.K, kb0); VMW(); SWRITE_KF(0); SBAR(); SLOAD_F((const float*)cur.V, kb0); }
    else { SLOAD_H(cur.K, cur.V, kb0); VMW(); SWRITE_HK(0); }
    __syncthreads();
}
template <class TIn, class TOut>
__device__ __forceinline__ void causal_swa_block(const BlockRef<TIn, TOut>& cur, const BlockRef<TIn, TOut>& nxt, int skv, int W, char* lds, Seam<TIn>& S) {
    constexpr bool F32 = same_t<TIn, float>::v;
    const int tid = threadIdx.x, wid = __builtin_amdgcn_readfirstlane(tid >> 6), lane = tid & 63, r32 = lane & 31, hi = lane >> 5;
    const int j_lo = swa_jlo(cur.P0, W);
    int j_hi = (cur.P0 + QB - 1) / KVBLK + 1; if (j_hi > skv / KVBLK) j_hi = skv / KVBLK;
    const int NT = j_hi - j_lo;
    const int kbn = swa_jlo(nxt.P0, W) * KVBLK;
    const int qlo = cur.P0 + wid * QBLK;
    char* V_lds = lds; char* K_lds = lds + 2 * SHM_V;
    float* ws = (float*)(lds + 2 * SHM_V + 2 * SHM_K) + wid * 64; float* li_l = ws, * al_l = ws + 32;
    float m_reg = -1e30f, l_reg = 0; f32x16 o[4] = {};
    const int sr = tid >> 4, sc = (tid & 15) * 8, vst0 = v_st(sr, sc), vst1 = v_st(32 + sr, sc), kws = KSWZ(sr, sc * 2);
    const int vb0 = (int)(uintptr_t)V_lds + v_rd_base(lane);
    const TIn* Kh = cur.K; const TIn* Vh = cur.V;
    unsigned long long mw_;
#define RESC(a) do { if (__any((a) < 1.f)) { if (hi == 0) al_l[r32] = (a); asm volatile("s_waitcnt lgkmcnt(0)" ::: "memory");              \
                     for (int d_ = 0; d_ < 4; ++d_) for (int r = 0; r < 16; ++r) o[d_][r] *= al_l[crow(r, hi)]; } } while (0)
#define KBASE(t) ((j_lo + (t)) * KVBLK)
#define ACT(t) (KBASE(t) <= qlo + QBLK - 1 && KBASE(t) + KVBLK - 1 >= qlo - W + 1)
#define MLOAD(t) (mw_ = cur.MW[(unsigned)((j_lo + (t)) * 4096 + cur.P0 + wid * QBLK + r32)])
#define MASKT(P0_, P1_, t) do { sel_tile(P0_, P1_, mw_, hi); } while (0)
    constexpr int NQL = F32 ? 16 : 8;
    constexpr bool SK = WSKIP && !F32;
#define SEAM_K0() do { VMWN(NQL); if constexpr (F32) { SWRITE_KF(0); SBAR(); SLOAD_F((const float*)nxt.V, kbn); } else { SWRITE_HK(0); } SBAR(); } while (0)
    f32x16 pA0, pA1, pB0, pB1; float mnA, mnB, alA, alB; bf16x8 pa0, pa1, pa2, pa3;
    if constexpr (F32) { VMW(); SWRITE_VF(0); SBAR(); } else { SWRITE_HV(0); SBAR(); }
    if (NT > 1) { if constexpr (F32) SLOAD_F((const float*)Kh, KBASE(1)); else SLOAD_H(Kh, Vh, KBASE(1)); }
    MLOAD(0); SBAR(); qkt<0, SK>(pA0, pA1, K_lds, r32, hi, S.qr, ACT(0));
    if constexpr (F32) { if (NT > 1) { VMW(); SWRITE_KF(1); SBAR(); SLOAD_F((const float*)Vh, KBASE(1)); } }
    MASKT(pA0, pA1, 0); partialSM(pA0, pA1, m_reg, mnA, alA);
    if (NT > 1) { VMW(); if constexpr (F32) { SWRITE_VF(1); SBAR(); if (NT > 2) SLOAD_F((const float*)Kh, KBASE(2)); } else SWRITE_H(1); }
    __syncthreads();
#define HALF_STEP(PX0, PX1, mnX, alX, PY0, PY1, alY, t, KB, VB, SB) do {                                                      \
        SBAR(); qkt<KB, SK>(PX0, PX1, K_lds, r32, hi, S.qr, ACT(t));                                             \
        finishSM(PY0, PY1, alY, l_reg, pa0, pa1, pa2, pa3); SBAR();                                                           \
        if ((t) + 1 < NT) { if constexpr (F32) { VMW(); SWRITE_KF(SB); SBAR(); SLOAD_F((const float*)Vh, KBASE((t) + 1)); }  \
                            else { SLOAD_H(Kh, Vh, KBASE((t) + 1)); } SBAR(); }                                               \
        MLOAD(t); SBAR(); pv_tile<VB, SK>(o, vb0, pa0, pa1, pa2, pa3, ACT((t) - 1)); MASKT(PX0, PX1, (t)); partialSM(PX0, PX1, m_reg, mnX, alX);                                        \
        __syncthreads();                                                                                                      \
        if ((t) + 1 < NT) { VMW(); if constexpr (F32) { SWRITE_VF(SB); SBAR(); if ((t) + 2 < NT) SLOAD_F((const float*)Kh, KBASE((t) + 2)); } \
                            else { SWRITE_H(SB); } }                                                                          \
        RESC(alX); __syncthreads(); } while (0)
    for (int t = 1; t + 1 < NT; t += 2) {
        HALF_STEP(pB0, pB1, mnB, alB, pA0, pA1, alA, t, 1, 0, 0);
        HALF_STEP(pA0, pA1, mnA, alA, pB0, pB1, alB, t + 1, 0, 1, 1);
    }
    const bool even = (NT & 1) == 0;
    if (even) { SBAR(); qkt<1, SK>(pB0, pB1, K_lds, r32, hi, S.qr, ACT(NT - 1)); SBAR(); }
#define QROW(e) (nxt.Q + (size_t)(wid * QBLK + r32) * QS + ((e) >> 1) * 16 + hi * 8 + ((e) & 1) * 4)
    if constexpr (F32) { SLOAD_F((const float*)nxt.K, kbn); SBAR();
#pragma unroll
        for (int e = 0; e < 8; ++e) S.tq[e] = *(const f32x4*)QROW(e); }
    else { SLOAD_H(nxt.K, nxt.V, kbn); SBAR();
#pragma unroll
        for (int d0 = 0; d0 < 8; ++d0) S.qr[d0] = load8<TIn>(nxt.Q + (size_t)(wid * QBLK + r32) * QS + d0 * 16 + hi * 8); }
    SBAR();
    finishSM(pA0, pA1, alA, l_reg, pa0, pa1, pa2, pa3); SBAR();
    if constexpr (F32) {
#pragma unroll
        for (int e = 8; e < 16; ++e) S.tq[e] = *(const f32x4*)QROW(e); SBAR(); }
#undef QROW
    pv_tile<0, SK>(o, vb0, pa0, pa1, pa2, pa3, ACT(even ? NT - 2 : NT - 1));
    if (even) { MLOAD(NT - 1); MASKT(pB0, pB1, NT - 1); partialSM(pB0, pB1, m_reg, mnB, alB); __syncthreads(); RESC(alB);
        finishSM(pB0, pB1, alB, l_reg, pa0, pa1, pa2, pa3); SBAR(); pv_tile<1, SK>(o, vb0, pa0, pa1, pa2, pa3, ACT(NT - 1)); }
    SBAR(); SEAM_K0();
    if (hi == 0) li_l[r32] = l_reg; asm volatile("s_waitcnt lgkmcnt(0)" ::: "memory");
    float rli[16];
#pragma unroll
    for (int r = 0; r < 16; ++r) rli[r] = __builtin_amdgcn_rcpf(li_l[crow(r, hi)]);
    TOut* Ow = cur.O + (size_t)(wid * QBLK) * OS;
#pragma unroll
    for (int r = 0; r < 16; ++r) { const int orow = crow(r, hi);
#pragma unroll
        for (int d0 = 0; d0 < 4; ++d0) { const float v = o[d0][r] * rli[r];
            if constexpr (same_t<TOut, float>::v) { Ow[(size_t)orow * OS + d0 * 32 + r32] = v; }
            else { const float vn = __builtin_bit_cast(float, __builtin_amdgcn_mov_dpp(__builtin_bit_cast(int, v), 0xB1, 0xf, 0xf, true));
                   if ((r32 & 1) == 0) *(unsigned*)(Ow + (size_t)orow * OS + d0 * 32 + r32) = cvtpk(v, vn); } } }
    if constexpr (F32) {
#pragma unroll
        for (int d0 = 0; d0 < 8; ++d0) S.qr[d0] = pack8(S.tq[2 * d0], S.tq[2 * d0 + 1]); }
    __syncthreads();
#undef RESC
#undef KBASE
#undef ACT
#undef MASKT
#undef MLOAD
#undef SEAM_K0
#undef HALF_STEP
}
#undef ROW
#undef VMW
#undef VMWN
#undef SLOAD_H
#undef SWRITE_HK
#undef SWRITE_HV
#undef SWRITE_H
#undef SLOAD_F
#undef SWRITE_KF
#undef SWRITE_VF

}
#define GAS __attribute__((address_space(1)))
#define LAS __attribute__((address_space(3)))
typedef unsigned short bf16;
typedef unsigned v4u __attribute__((ext_vector_type(4)));
typedef float f32x4 __attribute__((ext_vector_type(4)));
typedef short bf16x8 __attribute__((ext_vector_type(8)));
typedef GAS unsigned gu32;
typedef GAS unsigned long long gu64;
#define RLX_AGENT __ATOMIC_RELAXED, __HIP_MEMORY_SCOPE_AGENT
#define LDS_WAIT() asm volatile("s_waitcnt lgkmcnt(0)" ::: "memory")
#define VM_WAIT() asm volatile("s_waitcnt vmcnt(0)" ::: "memory")
__device__ __forceinline__ unsigned long long rt() { return __builtin_amdgcn_s_memrealtime(); }
__device__ __forceinline__ unsigned f2bf(float f) { unsigned u = __builtin_bit_cast(unsigned, f); return (u + 0x7fffu + ((u >> 16) & 1u)) >> 16; }
__device__ __forceinline__ unsigned pk2(float lo, float hi) { return f2bf(lo) | (f2bf(hi) << 16); }

#define XB_TMO      128
#define XB_XCNT(j)  (256  + 64 * (j))
#define XB_XSUB(j)  (1280 + 64 * (j))
#define XB_XGEN(j)  (2304 + 64 * (j))
#define XB_TOP      3328
#define XB_TOPGEN   3392
#define XCD_BAR_WORDS 3456
#define XB_SPIN_CAP (1u << 18)

__device__ __forceinline__ unsigned xb_ld(unsigned* p)              { return __hip_atomic_load(p, __ATOMIC_RELAXED, __HIP_MEMORY_SCOPE_AGENT); }
__device__ __forceinline__ unsigned xb_add(unsigned* p, unsigned v) { return __hip_atomic_fetch_add(p, v, __ATOMIC_RELAXED, __HIP_MEMORY_SCOPE_AGENT); }
__device__ __forceinline__ unsigned xb_xcc_id() { return (unsigned)__builtin_amdgcn_s_getreg((3 << 11) | 20) & 0xFu; }
#define XB_SPIN(cond, bar) do { unsigned _sp = 0; while (cond) { __builtin_amdgcn_s_sleep(1); \
    if ((++_sp & 255u) == 0u) { if (xb_ld(&(bar)[XB_TMO])) break; if (_sp > XB_SPIN_CAP) { atomicAdd(&(bar)[XB_TMO], 1u); break; } } } } while (0)

struct XcdBarrier {
    unsigned* bar; unsigned x;
    volatile LAS unsigned* st;
};

__device__ __forceinline__ XcdBarrier xcd_barrier_post(unsigned* bar, volatile LAS unsigned* st) {
    XcdBarrier b; b.bar = bar; b.x = xb_xcc_id(); b.st = st;
    if (threadIdx.x == 0) (void)xb_add(&bar[XB_XCNT(b.x)], 1u);
    return b;
}
__device__ __forceinline__ void xcd_barrier_complete(unsigned* bar, unsigned x, unsigned& nloc, unsigned& nx) {
    const unsigned G = gridDim.x * gridDim.y * gridDim.z;
    unsigned sum, cnt, mine, sp = 0u;
    for (;;) {
        sum = 0u; cnt = 0u; mine = 0u;
#pragma unroll
        for (unsigned j = 0; j < 16; ++j) { const unsigned c = xb_ld(&bar[XB_XCNT(j)]); sum += c; cnt += (c > 0u) ? 1u : 0u; mine = (j == x) ? c : mine; }
        if (sum == G) break;
        __builtin_amdgcn_s_sleep(1);
        if ((++sp & 255u) == 0u) { if (xb_ld(&bar[XB_TMO])) break; if (sp > XB_SPIN_CAP) { atomicAdd(&bar[XB_TMO], 1u); break; } }
    }
    nloc = mine > 0u ? mine : 1u; nx = cnt > 0u ? cnt : 1u;
}

__device__ __forceinline__ void xcd_barrier(const XcdBarrier& b) {
    asm volatile("s_waitcnt vmcnt(0)" ::: "memory");
    __syncthreads();
    if (threadIdx.x == 0) {
        unsigned* bar = b.bar;
        __builtin_amdgcn_s_waitcnt(0);
        unsigned nloc = b.st[0], nx = b.st[1];
        if (nloc == 0u) { xcd_barrier_complete(bar, b.x, nloc, nx); b.st[0] = nloc; b.st[1] = nx; }
        const unsigned old = xb_add(&bar[XB_XSUB(b.x)], 1u);
        const unsigned gen = old / nloc;
        if (old + 1u == (gen + 1u) * nloc) {
            __builtin_amdgcn_fence(__ATOMIC_RELEASE, "agent");
            asm volatile("s_waitcnt vmcnt(0)" ::: "memory");
            const unsigned og = xb_add(&bar[XB_TOP], 1u);
            const unsigned tg = og / nx;
            if (og + 1u == (tg + 1u) * nx) xb_add(&bar[XB_TOPGEN], 1u);
            else XB_SPIN(xb_ld(&bar[XB_TOPGEN]) == tg, bar);
            __builtin_amdgcn_fence(__ATOMIC_ACQUIRE, "agent");
            xb_add(&bar[XB_XGEN(b.x)], 1u);
            asm volatile("s_waitcnt vmcnt(0)" ::: "memory");
        } else {
            XB_SPIN(xb_ld(&bar[XB_XGEN(b.x)]) == gen, bar);
            __builtin_amdgcn_fence(__ATOMIC_ACQUIRE, "agent");
            asm volatile("s_waitcnt vmcnt(0)" ::: "memory");
        }
    }
    __syncthreads();
}
namespace mk {
constexpr int NWAVES = 8;
constexpr int D = 1024, MP = 16384, MS = 512, M = MP + MS, SEQ = 4096, NBATCH = 4, PAST = 2048;
constexpr int NE = 3072, ECOLS = 2888, NO = 1536, FF = 4096;
constexpr float ALPHA = 1.4142135623730951f, LN_EPS = 1e-5f;
constexpr float C2Q = 0.125f * 1.4426950408889634f;
constexpr size_t O_Y = 0, O_NAP = (size_t)M * D, O_NBP = O_NAP + (size_t)MP * 1024, O_NPP = O_NBP + (size_t)MP * 320,
                 O_NAS = O_NPP + 4 * 15 * 512, O_NBS = O_NAS + (size_t)MS * 1024, O_NPS = O_NBS + (size_t)MS * 320, O_NVS = O_NPS + 128 * 15 * 512,
                 O_END = O_NVS + (size_t)MS * 512;
constexpr size_t MiB = 1u << 20;
constexpr size_t WS_CTL = 0, CTL_ZERO_BYTES = 1 * MiB;
constexpr size_t WS_WINE = 2 * MiB, WS_WOUTE = 8 * MiB, WS_WINO = 10 * MiB, WS_WOUTO = 13 * MiB, WS_W1 = 16 * MiB, WS_W2 = 32 * MiB, WS_WPOOL = 48 * MiB, WS_WSB = 48 * MiB + 256 * 1024;
constexpr size_t WS_XN = 50 * MiB, WS_QA = 84 * MiB, WS_KA = 101 * MiB, WS_VA = 118 * MiB, WS_QB = 135 * MiB, WS_QI = 152 * MiB, WS_KB = 169 * MiB, WS_VB = 174 * MiB,
                 WS_KI = 179 * MiB, WS_WI = 182 * MiB, WS_OA = 183 * MiB, WS_MIX = 215 * MiB, WS_MASK = 248 * MiB, WS_MASKS = 256 * MiB, WS_SS = 257 * MiB,
                 WS_V = 262 * MiB, WS_X1 = 328 * MiB, WS_X2 = 394 * MiB, WS_XC = 460 * MiB, WS_U = 493 * MiB, WS_GV = 510 * MiB, WS_H = 544 * MiB, WS_S = 676 * MiB, WS_X3 = 932 * MiB, WS_MIX2 = 998 * MiB, WS_FAST_END = 1032 * MiB;
constexpr int SS_PITCH = 2112, MWS_PITCH = 40;
constexpr int CW_TMO = 0, CW_CODE = 1, CW_BAR = 4096, CW_Q0 = 8192;
constexpr int RING_BYTES = 131072, LDSCTL_OFF = RING_BYTES, MISC_OFF = LDSCTL_OFF + 320, LDS_BYTES = 147456;

typedef unsigned short bf16_t;
struct Args { const float* in[22]; float* out; unsigned char* ws; int ph_lo, ph_hi; };
typedef const __attribute__((address_space(4))) Args* KA;
struct Frame { LAS unsigned char* lds; volatile LAS unsigned* MISC; gu32* ctl; int tid, lane, wave, vcu, G; };

__device__ __forceinline__ float bf2f(unsigned short h) { return __uint_as_float((unsigned)h << 16); }
__device__ __forceinline__ unsigned cvtpk(float lo, float hi) { unsigned r; asm volatile("v_cvt_pk_bf16_f32 %0, %1, %2" : "=v"(r) : "v"(lo), "v"(hi)); return r; }
__device__ __forceinline__ float wave_sum(float v) {
#pragma unroll
    for (int o = 1; o < 64; o <<= 1) v += __shfl_xor(v, o);
    return v;
}
__device__ __forceinline__ float wave_max(float v) {
#pragma unroll
    for (int o = 1; o < 64; o <<= 1) v = fmaxf(v, __shfl_xor(v, o));
    return v;
}
__device__ __forceinline__ void block_sync() { asm volatile("s_waitcnt vmcnt(0) lgkmcnt(0)" ::: "memory"); __syncthreads(); }

__device__ __forceinline__ void transpose_item(const float* W, int K, int Nsrc, bf16_t* WT, int item, int nblk, LAS float* scr, int lane) {
    const int kb = item / nblk, nb = item % nblk, k0 = 64 * kb, n0 = 32 * nb;
    const int n_in = n0 + (lane & 31); const bool ok = n_in < Nsrc;
#pragma unroll 8
    for (int i = 0; i < 32; ++i) { const int kk = 2 * i + (lane >> 5); scr[kk * 33 + (lane & 31)] = ok ? W[(size_t)(k0 + kk) * Nsrc + n_in] : 0.f; }
    LDS_WAIT(); asm volatile("" ::: "memory");
    const int c = lane & 7;
#pragma unroll
    for (int j = 0; j < 4; ++j) { const int n = (lane >> 3) + 8 * j; const LAS float* s = scr + (8 * c) * 33 + n;
        v4u o; o.x = cvtpk(s[0 * 33], s[1 * 33]); o.y = cvtpk(s[2 * 33], s[3 * 33]); o.z = cvtpk(s[4 * 33], s[5 * 33]); o.w = cvtpk(s[6 * 33], s[7 * 33]);
        *(GAS v4u*)(WT + (size_t)(n0 + n) * K + k0 + 8 * c) = o; }
    LDS_WAIT(); asm volatile("" ::: "memory");
}
__device__ __forceinline__ void p0_prologue(Frame& F, KA A) {
    LAS float* scr = (LAS float*)(F.lds + F.wave * 16384);
    const int gw = F.vcu * NWAVES + F.wave, NGW = F.G * NWAVES;
    unsigned char* ws = A->ws;
    constexpr int I0 = 16 * 96, I1 = 16 * 32, I2 = 16 * 48, I3 = 16 * 32, I4 = 16 * 128, I5 = 64 * 32, I6 = 2 * 4;
    constexpr int NITEMS = I0 + I1 + I2 + I3 + 2 * I4 + 2 * I5 + 4 * I6;
    for (int it = gw; it < NITEMS; it += NGW) {
        int r = it;
        if (r < I0) { transpose_item(A->in[6], 1024, ECOLS, (bf16_t*)(ws + WS_WINE), r, 96, scr, F.lane); continue; } r -= I0;
        if (r < I1) { transpose_item(A->in[9], 1024, 1024, (bf16_t*)(ws + WS_WOUTE), r, 32, scr, F.lane); continue; } r -= I1;
        if (r < I2) { transpose_item(A->in[10], 1024, NO, (bf16_t*)(ws + WS_WINO), r, 48, scr, F.lane); continue; } r -= I2;
        if (r < I3) { transpose_item(A->in[17], 1024, 1024, (bf16_t*)(ws + WS_WOUTO), r, 32, scr, F.lane); continue; } r -= I3;
        if (r < 2 * I4) { const int l = r / I4; transpose_item(A->in[18] + (size_t)l * D * FF, 1024, FF, (bf16_t*)(ws + WS_W1) + (size_t)l * D * FF, r % I4, 128, scr, F.lane); continue; } r -= 2 * I4;
        if (r < 2 * I5) { const int l = r / I5; transpose_item(A->in[19] + (size_t)l * D * FF, FF, 1024, (bf16_t*)(ws + WS_W2) + (size_t)l * D * FF, r % I5, 32, scr, F.lane); continue; } r -= 2 * I5;
        { const int g = r / I6; transpose_item(A->in[11] + (size_t)g * 16384, 128, 128, (bf16_t*)(ws + WS_WPOOL) + (size_t)g * 16384, r % I6, 4, scr, F.lane); }
    }
    const int gt = F.vcu * (NWAVES * 64) + F.tid, NGT = F.G * NWAVES * 64;
    { bf16_t* wsb = (bf16_t*)(ws + WS_WSB); const float* w_s = A->in[15];
      for (int e = gt; e < 4 * 128 * 128; e += NGT) { const int i = (e >> 7) & 127, j = e & 127; wsb[e] = (bf16_t)(cvtpk(j <= i ? w_s[e] : 0.f, 0.f) & 0xffffu); } }
    { bf16_t* xn = (bf16_t*)(ws + WS_XN);
      for (int e = gt; e < M * D / 8; e += NGT) { const size_t off = (size_t)e * 8; const float* src = off < (size_t)MP * D ? A->in[0] + off : A->in[1] + (off - (size_t)MP * D);
          const f32x4 a = *(const GAS f32x4*)src, b = *(const GAS f32x4*)(src + 4); v4u o; o.x = cvtpk(a[0], a[1]); o.y = cvtpk(a[2], a[3]); o.z = cvtpk(b[0], b[1]); o.w = cvtpk(b[2], b[3]);
          *(GAS v4u*)(xn + off) = o; } }
}

__device__ __forceinline__ void ln_phase(Frame& F, const float* V, const float* g, const float* b, float* out, bf16_t* xn) {
    const int gw = F.vcu * NWAVES + F.wave, NGW = F.G * NWAVES;
    f32x4 gv[4], bv[4];
#pragma unroll
    for (int j = 0; j < 4; ++j) { gv[j] = *(const GAS f32x4*)(g + 4 * F.lane + 256 * j); bv[j] = *(const GAS f32x4*)(b + 4 * F.lane + 256 * j); }
    for (int m = gw; m < M; m += NGW) {
        const GAS f32x4* xr = (const GAS f32x4*)(V + (size_t)m * D) + F.lane;
        f32x4 v[4]; float s = 0.f;
#pragma unroll
        for (int j = 0; j < 4; ++j) { v[j] = xr[64 * j]; s += (v[j].x + v[j].y) + (v[j].z + v[j].w); }
        const float mean = wave_sum(s) * (1.f / D); float s2 = 0.f;
#pragma unroll
        for (int j = 0; j < 4; ++j) { v[j] = v[j] - mean; s2 += (v[j].x * v[j].x + v[j].y * v[j].y) + (v[j].z * v[j].z + v[j].w * v[j].w); }
        const float rstd = 1.f / sqrtf(wave_sum(s2) * (1.f / D) + LN_EPS);
        GAS f32x4* o4 = (GAS f32x4*)(out + (size_t)m * D) + F.lane;
#pragma unroll
        for (int j = 0; j < 4; ++j) { v[j] = v[j] * rstd * gv[j] + bv[j]; o4[64 * j] = v[j]; }
        if (xn) { GAS unsigned long long* o8 = (GAS unsigned long long*)(xn + (size_t)m * D) + F.lane;
#pragma unroll
            for (int j = 0; j < 4; ++j) o8[64 * j] = (unsigned long long)cvtpk(v[j].x, v[j].y) | ((unsigned long long)cvtpk(v[j].z, v[j].w) << 32); }
    }
}

typedef short bf16x8_t __attribute__((ext_vector_type(8)));
typedef float f32x16_t __attribute__((ext_vector_type(16)));
__device__ __forceinline__ void idx_scores_prompt(Frame& F, const bf16_t* QI, const bf16_t* KI, const float* WI, float* S) {
    const int gw = F.vcu * NWAVES + F.wave, NGW = F.G * NWAVES; const int fr = F.lane & 15, fq = F.lane >> 4;
    for (int item = gw; item < 4 * 1152; item += NGW) {
        const int b = item / 1152, r = item % 1152;
        int gq = 0; while (16 * (gq + 1) * (gq + 2) <= r) ++gq;
        const int r2 = r - 16 * gq * (gq + 1), qt = gq * 32 + r2 / (gq + 1), kc = r2 % (gq + 1);
        int ntile = qt + 1 - 32 * kc; ntile = ntile > 32 ? 32 : ntile;
        const size_t qrow = (size_t)b * SEQ + qt * 16 + fr;
        bf16x8_t qf[8][2];
#pragma unroll
        for (int h = 0; h < 8; ++h)
#pragma unroll
            for (int kk = 0; kk < 2; ++kk) qf[h][kk] = *(const GAS bf16x8_t*)(QI + qrow * 512 + h * 64 + kk * 32 + fq * 8);
        const f32x4 w0 = *(const GAS f32x4*)(WI + qrow * 8), w1 = *(const GAS f32x4*)(WI + qrow * 8 + 4);
        const bf16_t* kbase = KI + ((size_t)b * SEQ + (size_t)kc * 512 + fr) * 64 + fq * 8;
        float* sbase = S + qrow * 4096 + kc * 512 + 4 * fq;
        bf16x8_t kf0 = *(const GAS bf16x8_t*)(kbase), kf1 = *(const GAS bf16x8_t*)(kbase + 32);
        for (int kt = 0; kt < ntile; ++kt) {
            const bf16_t* knp = kbase + (size_t)(kt + 1 < ntile ? kt + 1 : kt) * 16 * 64;
            const bf16x8_t kn0 = *(const GAS bf16x8_t*)(knp), kn1 = *(const GAS bf16x8_t*)(knp + 32);
            f32x4 acc = {0.f, 0.f, 0.f, 0.f};
#define IDX_HEAD(h, wv) do { f32x4 p = {0.f, 0.f, 0.f, 0.f}; p = __builtin_amdgcn_mfma_f32_16x16x32_bf16(kf0, qf[h][0], p, 0, 0, 0); p = __builtin_amdgcn_mfma_f32_16x16x32_bf16(kf1, qf[h][1], p, 0, 0, 0); \
                acc[0] += (wv) * fmaxf(p[0], 0.f); acc[1] += (wv) * fmaxf(p[1], 0.f); acc[2] += (wv) * fmaxf(p[2], 0.f); acc[3] += (wv) * fmaxf(p[3], 0.f); } while (0)
            IDX_HEAD(0, w0[0]); IDX_HEAD(1, w0[1]); IDX_HEAD(2, w0[2]); IDX_HEAD(3, w0[3]); IDX_HEAD(4, w1[0]); IDX_HEAD(5, w1[1]); IDX_HEAD(6, w1[2]); IDX_HEAD(7, w1[3]);
#undef IDX_HEAD
            *(GAS f32x4*)(sbase + kt * 16) = acc;
            kf0 = kn0; kf1 = kn1;
        }
    }
}
__device__ __forceinline__ float xrow16_max(float x) {
    auto s = __builtin_amdgcn_permlane16_swap(__float_as_uint(x), __float_as_uint(x), false, false);
    x = fmaxf(__uint_as_float(s[0]), __uint_as_float(s[1]));
    auto t = __builtin_amdgcn_permlane32_swap(__float_as_uint(x), __float_as_uint(x), false, false);
    return fmaxf(__uint_as_float(t[0]), __uint_as_float(t[1]));
}
__device__ __forceinline__ float xrow16_sum(float x) {
    auto s = __builtin_amdgcn_permlane16_swap(__float_as_uint(x), __float_as_uint(x), false, false);
    x = __uint_as_float(s[0]) + __uint_as_float(s[1]);
    auto t = __builtin_amdgcn_permlane32_swap(__float_as_uint(x), __float_as_uint(x), false, false);
    return __uint_as_float(t[0]) + __uint_as_float(t[1]);
}
__device__ __forceinline__ const float* readlane_ptr(const float* p, int l) {
    const unsigned long long u = (unsigned long long)(uintptr_t)p;
    const unsigned lo = (unsigned)__builtin_amdgcn_readlane((int)(unsigned)u, l), hi = (unsigned)__builtin_amdgcn_readlane((int)(unsigned)(u >> 32), l);
    return (const float*)(uintptr_t)(((unsigned long long)hi << 32) | lo);
}
__device__ __forceinline__ bf16x8_t pack8f(f32x4 a, f32x4 b) { v4u w; w.x = cvtpk(a[0], a[1]); w.y = cvtpk(a[2], a[3]); w.z = cvtpk(b[0], b[1]); w.w = cvtpk(b[2], b[3]); return __builtin_bit_cast(bf16x8_t, w); }
typedef float f32x2_t __attribute__((ext_vector_type(2)));
template <int NR, bool MASKNEW>
__device__ __forceinline__ void dec_tile(const float* rowp, const bf16x8_t (&qf)[4], float sscale, float& m, float& l, f32x2_t (&o)[NR], int lane, LAS float* pscr) {
    const int fr = lane & 15, fq = lane >> 4;
    bf16x8_t kf[4];
#pragma unroll
    for (int kk = 0; kk < 4; ++kk) { const f32x4 a = *(const GAS f32x4*)(rowp + 32 * kk + 8 * fq), b = *(const GAS f32x4*)(rowp + 32 * kk + 8 * fq + 4); kf[kk] = pack8f(a, b); }
    f32x2_t v[16];
#pragma unroll
    for (int k = 0; k < 16; ++k) { const float* vp = readlane_ptr(rowp, k); v[k] = *(const GAS f32x2_t*)(vp + 128 + 2 * lane); __builtin_amdgcn_sched_barrier(0); }
    f32x4 st = {0.f, 0.f, 0.f, 0.f};
#pragma unroll
    for (int kk = 0; kk < 4; ++kk) st = __builtin_amdgcn_mfma_f32_16x16x32_bf16(kf[kk], qf[kk], st, 0, 0, 0);
#pragma unroll
    for (int j = 0; j < 4; ++j) { st[j] *= sscale; if (MASKNEW) { if (4 * fq + j > (fr & 3)) st[j] = -__builtin_inff(); } }
    float mt = fmaxf(fmaxf(st[0], st[1]), fmaxf(st[2], st[3])); mt = xrow16_max(mt);
    const float mn = fmaxf(m, mt), sc = __builtin_amdgcn_exp2f(m - mn); m = mn;
    float p[4];
#pragma unroll
    for (int j = 0; j < 4; ++j) p[j] = __builtin_amdgcn_exp2f(st[j] - mn);
    l = l * sc + ((p[0] + p[1]) + (p[2] + p[3]));
    if (fr < NR) {
#pragma unroll
        for (int j = 0; j < 4; ++j) pscr[(4 * fq + j) * NR + fr] = p[j]; }
    { const float s_all = sc; LAS float* ssc = pscr + 16 * NR; if (fq == 0 && fr < NR) ssc[fr] = s_all; }
    asm volatile("s_waitcnt lgkmcnt(0)" ::: "memory");
    { const LAS float* ssc = pscr + 16 * NR;
#pragma unroll
      for (int c4 = 0; c4 < NR / 4; ++c4) { const f32x4 s4 = *(const LAS f32x4*)(ssc + 4 * c4);
#pragma unroll
          for (int e = 0; e < 4; ++e) o[4 * c4 + e] = o[4 * c4 + e] * s4[e]; } }
#pragma unroll
    for (int k = 0; k < 16; ++k)
#pragma unroll
        for (int c4 = 0; c4 < NR / 4; ++c4) { const f32x4 p4 = *(const LAS f32x4*)(pscr + k * NR + 4 * c4);
#pragma unroll
            for (int e = 0; e < 4; ++e) o[4 * c4 + e] = o[4 * c4 + e] + v[k] * p4[e]; }
    asm volatile("s_waitcnt lgkmcnt(0)" ::: "memory");
}
constexpr int DEC_PSCR = 40960;
constexpr int MRG_ML = 0, MRG_OB = 1024, MRG_OA = MRG_OB + 8 * 8 * 128 * 4, MRG_MISC = MRG_OA + 4 * 128 * 4;
template <int NR>
__device__ __forceinline__ void dec_publish(Frame& F, float m, float l, const f32x2_t (&o)[NR]) {
    LAS float* ML = (LAS float*)(F.lds + MRG_ML); LAS float* OB = (LAS float*)(F.lds + MRG_OB);
    const float lt = xrow16_sum(l);
    if (F.lane < NR) { ML[(F.wave * 8 + F.lane) * 2] = m; ML[(F.wave * 8 + F.lane) * 2 + 1] = lt; }
#pragma unroll
    for (int c = 0; c < NR; ++c) *(LAS f32x2_t*)(OB + (F.wave * 8 + c) * 128 + 2 * F.lane) = o[c];
}
__device__ __forceinline__ f32x2_t dec_merged(Frame& F, int c) {
    const LAS float* ML = (const LAS float*)(F.lds + MRG_ML); const LAS float* OB = (const LAS float*)(F.lds + MRG_OB);
    float mm = -1e30f;
#pragma unroll
    for (int w = 0; w < 8; ++w) mm = fmaxf(mm, ML[(w * 8 + c) * 2]);
    float L = 0.f; f32x2_t O = {0.f, 0.f};
#pragma unroll
    for (int w = 0; w < 8; ++w) { const float e = __builtin_amdgcn_exp2f(ML[(w * 8 + c) * 2] - mm); L += ML[(w * 8 + c) * 2 + 1] * e; O = O + *(const LAS f32x2_t*)(OB + (w * 8 + c) * 128 + 2 * F.lane) * e; }
    return O * (1.f / L);
}
__device__ __forceinline__ float lam_value(const float* lam_e) {
    float la = 0.f, lb = 0.f;
    for (int d = 0; d < 64; ++d) { la += lam_e[d] * lam_e[64 + d]; lb += lam_e[128 + d] * lam_e[192 + d]; }
    return expf(la) - expf(lb) + 0.2f;
}
__device__ __forceinline__ void sample_diff_item(Frame& F, KA A, int b, int h) {
    const bf16_t* QA = (const bf16_t*)(A->ws + WS_QA); bf16_t* MIX = (bf16_t*)(A->ws + WS_MIX);
    const float* cache_a = A->in[2]; const int* pt = (const int*)A->in[5];
    const int lane = F.lane, fr = lane & 15, fq = lane >> 4;
    LAS float* pscr = (LAS float*)(F.lds + DEC_PSCR + F.wave * 1024);
    bf16x8_t qf[4];
    { const bf16x8_t z = {0, 0, 0, 0, 0, 0, 0, 0};
#pragma unroll
      for (int kk = 0; kk < 4; ++kk) { qf[kk] = z;
          if (fr < 4 && kk < 2) qf[kk] = *(const GAS bf16x8_t*)(QA + (size_t)(MP + 4 * b + fr) * 512 + h * 128 + 32 * kk + 8 * fq);
          if (fr >= 4 && fr < 8 && kk >= 2) qf[kk] = *(const GAS bf16x8_t*)(QA + (size_t)(MP + 4 * b + fr - 4) * 512 + h * 128 + 64 + 32 * (kk - 2) + 8 * fq); } }
    float m = -1e30f, l = 0.f; f32x2_t o[8];
#pragma unroll
    for (int c = 0; c < 8; ++c) o[c] = (f32x2_t){0.f, 0.f};
    for (int pp = 0; pp < 2; ++pp) {
        const int page = pt[b * 16 + 2 * F.wave + pp];
        const float* pbase = cache_a + ((size_t)page * 128) * 1024 + h * 256;
        for (int t = 0; t < 8; ++t) dec_tile<8, false>(pbase + (size_t)(16 * t + fr) * 1024, qf, 1.f, m, l, o, lane, pscr);
    }
    if (F.wave == 0) { const float* nrow = A->out + O_NAS + (size_t)(4 * b + (fr < 4 ? fr : 3)) * 1024 + h * 256; dec_tile<8, true>(nrow, qf, 1.f, m, l, o, lane, pscr); }
    dec_publish<8>(F, m, l, o);
    if (F.tid == 0) *(LAS float*)(F.lds + MRG_MISC) = lam_value(A->in[7]);
    block_sync();
    if (F.wave < 4) {
        const float lam = *(const LAS float*)(F.lds + MRG_MISC);
        const f32x2_t o1 = dec_merged(F, F.wave), o2 = dec_merged(F, 4 + F.wave);
        const f32x2_t oa = o1 - o2 * lam;
        const float ss = wave_sum(oa.x * oa.x + oa.y * oa.y), r = 1.f / sqrtf(ss * (1.f / 128.f) + LN_EPS);
        const f32x2_t g = *(const GAS f32x2_t*)(A->in[8] + 2 * lane);
        *(GAS unsigned*)(MIX + (size_t)(MP + 4 * b + F.wave) * 1024 + h * 128 + 2 * lane) = cvtpk(oa.x * r * g.x * 0.8f, oa.y * r * g.y * 0.8f);
    }
    block_sync();
}
__device__ __forceinline__ void sample_sparse_item(Frame& F, KA A, int b, int i) {
    const bf16_t* QB = (const bf16_t*)(A->ws + WS_QB); bf16_t* MIX = (bf16_t*)(A->ws + WS_MIX);
    const unsigned long long* MWS = (const unsigned long long*)(A->ws + WS_MASKS) + (size_t)(4 * b + i) * MWS_PITCH;
    const float* cache_b = A->in[3]; const int* pt = (const int*)A->in[5];
    const int lane = F.lane, fr = lane & 15, fq = lane >> 4;
    LAS int* idx = (LAS int*)(F.lds + MRG_MISC + 64);
    LAS float* pscr = (LAS float*)(F.lds + DEC_PSCR + F.wave * 1024);
    if (F.tid < 256) idx[F.tid] = 0;
    block_sync();
    if (F.wave == 0) { int pos = 0;
#pragma unroll 1
        for (int wi = 0; wi < 33; ++wi) { const unsigned long long w = MWS[wi]; const unsigned long long below = w & ((1ull << lane) - 1ull);
            if ((w >> lane) & 1ull) { const int q = pos + __builtin_popcountll(below); if (q < 256) idx[q] = 64 * wi + lane; }
            pos += __builtin_popcountll(w); } }
    block_sync();
    bf16x8_t qf[4];
    { const bf16x8_t z = {0, 0, 0, 0, 0, 0, 0, 0};
#pragma unroll
      for (int kk = 0; kk < 4; ++kk) { qf[kk] = z; if (fr < 4) qf[kk] = *(const GAS bf16x8_t*)(QB + (size_t)(MP + 4 * b + i) * 512 + fr * 128 + 32 * kk + 8 * fq); } }
    float m = -1e30f, l = 0.f; f32x2_t o[4];
#pragma unroll
    for (int c = 0; c < 4; ++c) o[c] = (f32x2_t){0.f, 0.f};
    for (int t = 0; t < 2; ++t) {
        const int key = idx[32 * F.wave + 16 * t + fr];
        const float* rowp = key < PAST ? cache_b + ((size_t)pt[b * 16 + (key >> 7)] * 128 + (key & 127)) * 320 : A->out + O_NBS + (size_t)(4 * b + (key - PAST)) * 320;
        dec_tile<4, false>(rowp, qf, 0.08838834764831845f * 1.4426950408889634f, m, l, o, lane, pscr);
    }
    dec_publish<4>(F, m, l, o);
    block_sync();
    if (F.wave < 4) { const f32x2_t ob = dec_merged(F, F.wave);
        *(GAS unsigned*)(MIX + (size_t)(MP + 4 * b + i) * 1024 + 512 + F.wave * 128 + 2 * lane) = cvtpk(ob.x, ob.y); }
    block_sync();
}
__device__ __forceinline__ void sample_idx_item(Frame& F, KA A, int b, int hf) {
    const bf16_t* QI = (const bf16_t*)(A->ws + WS_QI); const float* WI = (const float*)(A->ws + WS_WI); float* SS = (float*)(A->ws + WS_SS);
    const float* cache_b = A->in[3]; const int* pt = (const int*)A->in[5];
    LAS float* qs = (LAS float*)(F.lds); LAS float* wsh = qs + 2048;
    for (int e = F.tid; e < 2048; e += NWAVES * 64) qs[e] = bf2f(QI[(size_t)(MP + 4 * b + (e >> 9)) * 512 + (e & 511)]);
    if (F.tid < 32) wsh[F.tid] = WI[(size_t)(MP + 4 * b + (F.tid >> 3)) * 8 + (F.tid & 7)];
    block_sync();
    const int g0 = hf ? 17 : 0, g1 = hf ? 33 : 17;
    for (int g = g0 + F.wave; g < g1; g += NWAVES) {
        const int key = 64 * g + F.lane; const bool valid = key < PAST + 4;
        const int kc = valid ? key : PAST + 3;
        const float* rowp = kc < PAST ? cache_b + ((size_t)pt[b * 16 + (kc >> 7)] * 128 + (kc & 127)) * 320 + 256 : A->out + O_NBS + (size_t)(4 * b + (kc - PAST)) * 320 + 256;
        f32x4 kv[16];
#pragma unroll
        for (int j = 0; j < 16; ++j) kv[j] = *(const GAS f32x4*)(rowp + 4 * j);
        float sc[4] = {0.f, 0.f, 0.f, 0.f};
#pragma unroll
        for (int i = 0; i < 4; ++i)
#pragma unroll
            for (int h = 0; h < 8; ++h) { float a = 0.f;
#pragma unroll
                for (int j = 0; j < 16; ++j) { const f32x4 q = *(const LAS f32x4*)(qs + i * 512 + h * 64 + 4 * j); a += (q[0] * kv[j][0] + q[1] * kv[j][1]) + (q[2] * kv[j][2] + q[3] * kv[j][3]); }
                sc[i] += wsh[i * 8 + h] * fmaxf(a, 0.f); }
        if (valid) {
#pragma unroll
            for (int i = 0; i < 4; ++i) SS[(size_t)(4 * b + i) * SS_PITCH + key] = sc[i]; }
    }
    block_sync();
}

__device__ __forceinline__ unsigned okey(float f) { const unsigned u = __float_as_uint(f); return (u & 0x80000000u) ? ~u : (u | 0x80000000u); }
#define CMP_GE_U32(w, k, s) asm volatile("v_cmp_ge_u32_e64 %0, %1, %2" : "=s"(w) : "v"(k), "s"(s))
#define CMP_GT_U32(w, k, s) asm volatile("v_cmp_gt_u32_e64 %0, %1, %2" : "=s"(w) : "v"(k), "s"(s))
#define CMP_EQ_U32(w, k, s) asm volatile("v_cmp_eq_u32_e64 %0, %1, %2" : "=s"(w) : "v"(k), "s"(s))
template <int NR>
__device__ __forceinline__ void topk_row(const float* srow, int n, int lane, unsigned long long& mine  ) {
    unsigned key[NR];
#pragma unroll
    for (int i = 0; i < NR; ++i) { const int j = lane + 64 * i; key[i] = j < n ? okey(srow[j < n ? j : 0]) : 0u; }
    unsigned P = 0u; bool exact = false;
    for (int bit = 31; bit >= 0; --bit) {
        const unsigned cand = P | (1u << bit); int c = 0;
#pragma unroll
        for (int i = 0; i < NR; ++i) { unsigned long long w; CMP_GE_U32(w, key[i], cand); c += __builtin_popcountll(w); }
        if (c >= 256) { P = cand; if (c == 256) { exact = true; break; } }
    }
    int need = 0;
    if (!exact) { int cg = 0;
#pragma unroll
        for (int i = 0; i < NR; ++i) { unsigned long long w; CMP_GT_U32(w, key[i], P); cg += __builtin_popcountll(w); }
        need = 256 - cg; }
    const unsigned Pc = exact ? P - 1u : P;
    unsigned lo_ = 0u, hi_ = 0u;
#pragma unroll
    for (int i = 0; i < NR; ++i) {
        unsigned long long w; CMP_GT_U32(w, key[i], Pc);
        if (need > 0) { unsigned long long eq; CMP_EQ_U32(eq, key[i], P);
            while (need > 0 && eq) { const unsigned long long lowbit = eq & (~eq + 1ull); w |= lowbit; eq ^= lowbit; --need; } }
        const unsigned wl = (unsigned)w, wh = (unsigned)(w >> 32);
        asm volatile("v_writelane_b32 %0, %1, %2" : "+v"(lo_) : "s"(wl), "n"(i)); asm volatile("v_writelane_b32 %0, %1, %2" : "+v"(hi_) : "s"(wh), "n"(i));
    }
    mine = ((unsigned long long)hi_ << 32) | lo_;
}
__device__ __forceinline__ void topk_phase(Frame& F, KA A) {
    const float* S = (const float*)(A->ws + WS_S); const float* SS = (const float*)(A->ws + WS_SS);
    unsigned long long* MW = (unsigned long long*)(A->ws + WS_MASK); unsigned long long* MWS = (unsigned long long*)(A->ws + WS_MASKS);
    const int gw = F.vcu * NWAVES + F.wave, NGW = F.G * NWAVES, lane = F.lane;
    for (int p = gw; p < 2048; p += NGW)
        for (int j = 0; j < 8; ++j) {
            const int b = j >> 1, t = (j & 1) ? 4095 - p : p, n = t + 1;
            const float* srow = S + ((size_t)b * SEQ + t) * 4096;
            unsigned long long mine = (64 * lane + 64 <= n) ? ~0ull : ((64 * lane < n) ? ((1ull << (n - 64 * lane)) - 1ull) : 0ull);
            if (n > 256) {
                if (n <= 1024) topk_row<16>(srow, n, lane, mine);
                else if (n <= 2048) topk_row<32>(srow, n, lane, mine);
                else if (n <= 3072) topk_row<48>(srow, n, lane, mine);
                else topk_row<64>(srow, n, lane, mine);
            }
            if (lane < 4 * (t / 256 + 1)) MW[((size_t)b * 64 + lane) * 4096 + t] = mine;
        }
    for (int r = gw; r < MS; r += NGW) {
        unsigned long long mine; topk_row<48>(SS + (size_t)r * SS_PITCH, PAST + (r & 3) + 1, lane, mine);
        if (lane < 33) MWS[(size_t)r * MWS_PITCH + lane] = mine;
    }
}

__device__ __forceinline__ void diff_combine_phase(Frame& F, KA A) {
    const bf16_t* OA = (const bf16_t*)(A->ws + WS_OA); bf16_t* MIX = (bf16_t*)(A->ws + WS_MIX);
    const int gw = F.vcu * NWAVES + F.wave, NGW = F.G * NWAVES, lane = F.lane;
    const float lam = lam_value(A->in[7]);
    f32x4 g0 = *(const GAS f32x4*)(A->in[8] + (lane & 15) * 8), g1 = *(const GAS f32x4*)(A->in[8] + (lane & 15) * 8 + 4);
    for (int m = gw; m < MP; m += NGW) {
        const v4u a = *(const GAS v4u*)(OA + (size_t)m * 1024 + lane * 8), c = *(const GAS v4u*)(OA + (size_t)m * 1024 + 512 + lane * 8);
        float o[8]; float ss = 0.f;
#pragma unroll
        for (int e = 0; e < 4; ++e) { const unsigned ua = a[e], uc = c[e];
            o[2 * e] = __uint_as_float(ua << 16) - lam * __uint_as_float(uc << 16); o[2 * e + 1] = __uint_as_float(ua & 0xffff0000u) - lam * __uint_as_float(uc & 0xffff0000u); }
#pragma unroll
        for (int e = 0; e < 8; ++e) ss += o[e] * o[e];
        ss += __shfl_xor(ss, 1); ss += __shfl_xor(ss, 2); ss += __shfl_xor(ss, 4); ss += __shfl_xor(ss, 8);
        const float r = 0.8f / sqrtf(ss * (1.f / 128.f) + LN_EPS);
        v4u w; w.x = cvtpk(o[0] * r * g0[0], o[1] * r * g0[1]); w.y = cvtpk(o[2] * r * g0[2], o[3] * r * g0[3]); w.z = cvtpk(o[4] * r * g1[0], o[5] * r * g1[1]); w.w = cvtpk(o[6] * r * g1[2], o[7] * r * g1[3]);
        *(GAS v4u*)(MIX + (size_t)m * 1024 + lane * 8) = w;
    }
}
constexpr int OM_STAT = 0, OM_XCG = 1024, OM_XP = 132, OM_VTG = 76544, OM_VP = 136;
__device__ __forceinline__ void odd_chunk_item(Frame& F, KA A, int k) {
    const float* XC = (const float*)(A->ws + WS_XC); const bf16_t* U = (const bf16_t*)(A->ws + WS_U); const float* GV = (const float*)(A->ws + WS_GV);
    const bf16_t* WPT = (const bf16_t*)(A->ws + WS_WPOOL); const bf16_t* WSB = (const bf16_t*)(A->ws + WS_WSB); bf16_t* MIX = (bf16_t*)(A->ws + WS_MIX2);
    const float* pool_scale = A->in[12]; const float* sgu_g = A->in[13]; const float* sgu_b = A->in[14]; const float* b_s = A->in[16];
    const int R0 = 128 * k, t0 = R0 % SEQ, lane = F.lane, fr = lane & 15, fq = lane >> 4, w = F.wave;
    LAS float* STAT = (LAS float*)(F.lds + OM_STAT); LAS float* XCG = (LAS float*)(F.lds + OM_XCG); LAS bf16_t* VTG = (LAS bf16_t*)(F.lds + OM_VTG);
    for (int j = 16 * w; j < 16 * w + 16; ++j) {
        const f32x4 a = *(const GAS f32x4*)(GV + (size_t)(R0 + j) * 512 + 4 * lane), c = *(const GAS f32x4*)(GV + (size_t)(R0 + j) * 512 + 256 + 4 * lane);
        const float mean = wave_sum((a[0] + a[1]) + (a[2] + a[3]) + (c[0] + c[1]) + (c[2] + c[3])) * (1.f / 512.f);
        float q = 0.f;
#pragma unroll
        for (int e = 0; e < 4; ++e) { const float d0 = a[e] - mean, d1 = c[e] - mean; q += d0 * d0 + d1 * d1; }
        const float rstd = 1.f / sqrtf(wave_sum(q) * (1.f / 512.f) + LN_EPS);
        if (lane == 0) { STAT[2 * j] = mean; STAT[2 * j + 1] = rstd; }
    }
    block_sync();
    for (int g = 0; g < 4; ++g) {
        for (int e = F.tid; e < 143 * 32; e += NWAVES * 64) { const int rr = e >> 5, c4 = (e & 31) * 4;
            f32x4 v = {0.f, 0.f, 0.f, 0.f}; if (t0 - 15 + rr >= 0) v = *(const GAS f32x4*)(XC + (size_t)(R0 - 15 + rr) * 512 + g * 128 + c4);
            *(LAS f32x4*)(XCG + rr * OM_XP + c4) = v; }
        { const f32x2_t sg = *(const GAS f32x2_t*)(sgu_g + g * 128 + 2 * lane), sb = *(const GAS f32x2_t*)(sgu_b + g * 128 + 2 * lane);
          for (int j = 16 * w; j < 16 * w + 16; ++j) { const f32x2_t v = *(const GAS f32x2_t*)(GV + (size_t)(R0 + j) * 512 + g * 128 + 2 * lane);
              const float mean = STAT[2 * j], rstd = STAT[2 * j + 1];
              const unsigned pk = cvtpk((v.x - mean) * rstd * sg.x + sb.x, (v.y - mean) * rstd * sg.y + sb.y);
              VTG[(2 * lane) * OM_VP + j] = (bf16_t)(pk & 0xffffu); VTG[(2 * lane + 1) * OM_VP + j] = (bf16_t)(pk >> 16); } }
        block_sync();
        { const int i = 16 * w + fr; bf16x8_t yf[4];
          const int kkmax = (16 * w + 15) >> 5;
#pragma unroll
          for (int kk = 0; kk < 4; ++kk) yf[kk] = *(const GAS bf16x8_t*)(WSB + ((size_t)g * 128 + i) * 128 + 32 * kk + 8 * fq);
          const float bsi = b_s[g * 128 + i];
          for (int ct = 0; ct < 8; ++ct) {
              f32x4 acc = {0.f, 0.f, 0.f, 0.f};
#pragma unroll
              for (int kk = 0; kk < 4; ++kk) if (kk <= kkmax) { const bf16x8_t xf = *(const LAS bf16x8_t*)(VTG + (16 * ct + fr) * OM_VP + 32 * kk + 8 * fq); acc = __builtin_amdgcn_mfma_f32_16x16x32_bf16(xf, yf[kk], acc, 0, 0, 0); }
              const unsigned long long uu = *(const GAS unsigned long long*)(U + (size_t)(R0 + i) * 512 + g * 128 + 16 * ct + 4 * fq);
              const float u0 = __uint_as_float((unsigned)uu << 16), u1 = __uint_as_float((unsigned)uu & 0xffff0000u), u2 = __uint_as_float((unsigned)(uu >> 32) << 16), u3 = __uint_as_float((unsigned)(uu >> 32) & 0xffff0000u);
              const unsigned long long o = (unsigned long long)cvtpk(u0 * (acc[0] + bsi), u1 * (acc[1] + bsi)) | ((unsigned long long)cvtpk(u2 * (acc[2] + bsi), u3 * (acc[3] + bsi)) << 32);
              *(GAS unsigned long long*)(MIX + (size_t)(R0 + i) * 1024 + 512 + g * 128 + 16 * ct + 4 * fq) = o;
          } }
        { const int t = 16 * w + fr, rr = t + 15, W = 2 << g; const int tpos = t0 + t; const float inv = 1.f / (float)(W < tpos + 1 ? W : tpos + 1);
          bf16x8_t yf[4];
#pragma unroll
          for (int kk = 0; kk < 4; ++kk) { const LAS float* base = XCG + rr * OM_XP + 32 * kk + 8 * fq;
              f32x4 s0 = {0.f, 0.f, 0.f, 0.f}, s1 = {0.f, 0.f, 0.f, 0.f};
              for (int q = 0; q < W; ++q) { s0 = s0 + *(const LAS f32x4*)(base - q * OM_XP); s1 = s1 + *(const LAS f32x4*)(base - q * OM_XP + 4); }
              const f32x4 x0 = *(const LAS f32x4*)base, x1 = *(const LAS f32x4*)(base + 4);
              yf[kk] = pack8f(s0 * inv - x0, s1 * inv - x1); }
          for (int dt = 0; dt < 8; ++dt) {
              f32x4 acc = {0.f, 0.f, 0.f, 0.f};
#pragma unroll
              for (int kk = 0; kk < 4; ++kk) { const bf16x8_t xf = *(const GAS bf16x8_t*)(WPT + ((size_t)g * 128 + 16 * dt + fr) * 128 + 32 * kk + 8 * fq); acc = __builtin_amdgcn_mfma_f32_16x16x32_bf16(xf, yf[kk], acc, 0, 0, 0); }
              const f32x4 ps = *(const GAS f32x4*)(pool_scale + g * 128 + 16 * dt + 4 * fq);
              const unsigned long long o = (unsigned long long)cvtpk(acc[0] * ps[0], acc[1] * ps[1]) | ((unsigned long long)cvtpk(acc[2] * ps[2], acc[3] * ps[3]) << 32);
              *(GAS unsigned long long*)(MIX + (size_t)(R0 + t) * 1024 + g * 128 + 16 * dt + 4 * fq) = o;
          } }
        block_sync();
    }
    if ((k & 31) == 31) {
        const int b = k >> 5;
        for (int e = F.tid; e < 15 * 512; e += NWAVES * 64) A->out[O_NPP + (size_t)b * 15 * 512 + e] = XC[(size_t)(R0 + 113) * 512 + e];
    }
}
__device__ __forceinline__ void odd_sample_item(Frame& F, KA A, int b) {
    const float* XC = (const float*)(A->ws + WS_XC); const bf16_t* U = (const bf16_t*)(A->ws + WS_U); const float* GV = (const float*)(A->ws + WS_GV); bf16_t* MIX = (bf16_t*)(A->ws + WS_MIX2);
    const float* state_pool = A->in[4]; const float* w_pool = A->in[11]; const float* pool_scale = A->in[12]; const float* sgu_g = A->in[13]; const float* sgu_b = A->in[14];
    const float* w_s = A->in[15]; const float* b_s = A->in[16];
    LAS float* EXT = (LAS float*)(F.lds); LAS float* VN = EXT + 19 * 512; LAS float* PL = VN + 4 * 512;
    const int lane = F.lane; const size_t r0 = (size_t)MP + 4 * b;
    for (int e = F.tid; e < 19 * 512; e += NWAVES * 64) EXT[e] = e < 15 * 512 ? state_pool[(size_t)b * 15 * 512 + e] : XC[r0 * 512 + (e - 15 * 512)];
    if (F.wave < 4) { const int i = F.wave;
        const f32x4 a = *(const GAS f32x4*)(GV + (r0 + i) * 512 + 4 * lane), c = *(const GAS f32x4*)(GV + (r0 + i) * 512 + 256 + 4 * lane);
        const float mean = wave_sum((a[0] + a[1]) + (a[2] + a[3]) + (c[0] + c[1]) + (c[2] + c[3])) * (1.f / 512.f);
        float q = 0.f;
#pragma unroll
        for (int e = 0; e < 4; ++e) { const float d0 = a[e] - mean, d1 = c[e] - mean; q += d0 * d0 + d1 * d1; }
        const float rstd = 1.f / sqrtf(wave_sum(q) * (1.f / 512.f) + LN_EPS);
        const f32x4 g0 = *(const GAS f32x4*)(sgu_g + 4 * lane), g1 = *(const GAS f32x4*)(sgu_g + 256 + 4 * lane), b0 = *(const GAS f32x4*)(sgu_b + 4 * lane), b1 = *(const GAS f32x4*)(sgu_b + 256 + 4 * lane);
        const f32x4 v0 = (a - mean) * rstd * g0 + b0, v1 = (c - mean) * rstd * g1 + b1;
        *(LAS f32x4*)(VN + i * 512 + 4 * lane) = v0; *(LAS f32x4*)(VN + i * 512 + 256 + 4 * lane) = v1;
        *(GAS f32x4*)(A->out + O_NVS + (size_t)(4 * b + i) * 512 + 4 * lane) = v0; *(GAS f32x4*)(A->out + O_NVS + (size_t)(4 * b + i) * 512 + 256 + 4 * lane) = v1; }
    block_sync();
    { const int c = F.tid, g = c >> 7, W = 2 << g;
#pragma unroll
      for (int i = 0; i < 4; ++i) { float s = 0.f; for (int q = 0; q < W; ++q) s += EXT[(15 + i - q) * 512 + c]; PL[i * 512 + c] = s / (float)W - EXT[(15 + i) * 512 + c];
          float sg = b_s[g * 128 + i]; for (int j = 0; j <= i; ++j) sg += w_s[((size_t)g * 128 + i) * 128 + j] * VN[j * 512 + c];
          MIX[(r0 + i) * 1024 + 512 + c] = (bf16_t)(cvtpk(bf2f(U[(r0 + i) * 512 + c]) * sg, 0.f) & 0xffffu); }
      for (int r = 0; r < 15; ++r) A->out[O_NPS + ((size_t)b * 15 + r) * 512 + c] = EXT[(r + 4) * 512 + c]; }
    block_sync();
    { const int c = F.tid, g = c >> 7, d = c & 127; float a0 = 0.f, a1 = 0.f, a2 = 0.f, a3 = 0.f;
      for (int q = 0; q < 128; ++q) { const float wv = w_pool[((size_t)g * 128 + q) * 128 + d]; a0 += PL[g * 128 + q] * wv; a1 += PL[512 + g * 128 + q] * wv; a2 += PL[1024 + g * 128 + q] * wv; a3 += PL[1536 + g * 128 + q] * wv; }
      const float ps = pool_scale[c];
      MIX[(r0 + 0) * 1024 + c] = (bf16_t)(cvtpk(a0 * ps, 0.f) & 0xffffu); MIX[(r0 + 1) * 1024 + c] = (bf16_t)(cvtpk(a1 * ps, 0.f) & 0xffffu);
      MIX[(r0 + 2) * 1024 + c] = (bf16_t)(cvtpk(a2 * ps, 0.f) & 0xffffu); MIX[(r0 + 3) * 1024 + c] = (bf16_t)(cvtpk(a3 * ps, 0.f) & 0xffffu); }
    block_sync();
}
__device__ __forceinline__ void sparse_prompt_part(unsigned char* ws, int vcu, int G, char* lds_generic) {
    typedef swa128::BlockRef<__hip_bfloat16, __hip_bfloat16> Ref;
    const __hip_bfloat16* QB = (const __hip_bfloat16*)(ws + WS_QB); const __hip_bfloat16* KB = (const __hip_bfloat16*)(ws + WS_KB); const __hip_bfloat16* VB = (const __hip_bfloat16*)(ws + WS_VB);
    __hip_bfloat16* MIX = (__hip_bfloat16*)(ws + WS_MIX); const unsigned long long* MW = (const unsigned long long*)(ws + WS_MASK);
    int it = vcu;
    if (it < 256) {
        auto mkref = [&](int item) { const int qb = 15 - (item >> 4), bh = item & 15, b = bh >> 2, h = bh & 3; Ref r;
            r.Q = QB + ((size_t)b * SEQ + (size_t)qb * 256) * 512 + h * 128; r.K = KB + (size_t)b * SEQ * 128; r.V = VB + (size_t)b * SEQ * 128;
            r.O = MIX + ((size_t)b * SEQ + (size_t)qb * 256) * 1024 + 512 + h * 128; r.P0 = qb * 256; r.MW = MW + (size_t)b * 64 * 4096; return r; };
        Ref cur = mkref(it);
        swa128::Seam<__hip_bfloat16> S;
        swa128::causal_swa_prime<__hip_bfloat16, __hip_bfloat16>(cur, 1 << 30, lds_generic, S);
        for (;;) {
            const int itn = it + G; const bool last = itn >= 256;
            const Ref nxt = last ? cur : mkref(itn);
            swa128::causal_swa_block<__hip_bfloat16, __hip_bfloat16>(cur, nxt, SEQ, 1 << 30, lds_generic, S);
            if (last) break;
            cur = nxt; it = itn;
        }
    }
}
__device__ __forceinline__ void att_phase(Frame& F, KA A, char* lds_generic) {
    unsigned char* ws = A->ws;
#ifndef MK_P4
#define MK_P4 7
#endif
    if (MK_P4 & 1) for (int it = F.vcu; it < MS; it += F.G) sample_sparse_item(F, A, it >> 2, it & 3);
    if (MK_P4 & 2) { sparse_prompt_part(ws, F.vcu, F.G, lds_generic); block_sync(); }
    {
        const attn_body::bf16* QA = (const attn_body::bf16*)(ws + WS_QA); const attn_body::bf16* KA = (const attn_body::bf16*)(ws + WS_KA); const attn_body::bf16* VA = (const attn_body::bf16*)(ws + WS_VA);
        attn_body::bf16* OA = (attn_body::bf16*)(ws + WS_OA);
        if (MK_P4 & 4) for (;;) {
            if (F.tid == 0) F.MISC[0] = __hip_atomic_fetch_add((unsigned*)(F.ctl + CW_Q0), 1u, __ATOMIC_RELAXED, __HIP_MEMORY_SCOPE_AGENT);
            block_sync();
            const int u = (int)F.MISC[0];
            if (u >= 1024) break;
            const int qb = 15 - (u >> 6), bp = u & 63, b = bp >> 4, p = bp & 15, h = p >> 2, s = (p >> 1) & 1, vh = p & 1;
            const size_t rb = (size_t)b * SEQ;
            attn_body::attn_unit<8>(qb, QA + rb * 512 + h * 128 + s * 64, KA + rb * 512 + h * 128 + s * 64, VA + rb * 512 + h * 128 + vh * 64,
                                    OA + rb * 1024 + s * 512 + h * 128 + vh * 64, lds_generic);
        }
        block_sync();
    }
}

__global__ void __launch_bounds__(NWAVES * 64, 2) mk_fwd(Args args) {
    extern __shared__ __attribute__((aligned(16))) unsigned char lds[];
    Frame F;
    F.lds = (LAS unsigned char*)lds; F.MISC = (volatile LAS unsigned*)(F.lds + MISC_OFF);
    F.tid = threadIdx.x; F.lane = F.tid & 63; F.wave = __builtin_amdgcn_readfirstlane(F.tid >> 6);
    F.G = gridDim.x; { const int bx = blockIdx.x; F.vcu = (F.G % 8 == 0) ? (bx % 8) * (F.G / 8) + bx / 8 : bx; }
    F.ctl = (gu32*)(args.ws + WS_CTL);
    for (int u = F.tid; u < (LDS_BYTES - LDSCTL_OFF) / 4; u += NWAVES * 64) ((LAS unsigned*)(F.lds + LDSCTL_OFF))[u] = 0u;
    __syncthreads();
#define PHASE_ARGS() ({ unsigned long long p_ = (unsigned long long)__builtin_amdgcn_kernarg_segment_ptr(); asm volatile("" : "+s"(p_)); (KA)p_; })
    const bool multi = (args.ph_hi - args.ph_lo) > 1;
    XcdBarrier bar; bar.bar = (unsigned*)(F.ctl + CW_BAR); bar.x = 0; bar.st = nullptr;
    if (multi) bar = xcd_barrier_post((unsigned*)(F.ctl + CW_BAR), F.MISC + 8);
#ifndef MK_PHASE_MASK
#define MK_PHASE_MASK 0x3ffff
#endif
#define IN(k) ((((MK_PHASE_MASK) >> (k)) & 1) && ({ KA a_ = PHASE_ARGS(); (a_->ph_lo <= (k) && (k) < a_->ph_hi); }))
#define SEAM(k) do { if (IN(k) && IN((k) + 1)) xcd_barrier(bar); } while (0)
#define WSP(T, off) ((T*)(A->ws + (off)))
    if (IN(0)) { KA A = PHASE_ARGS(); p0_prologue(F, A); } SEAM(0);
    if (IN(1)) { KA A = PHASE_ARGS();
        pg8::Gemm g{WSP(bf16_t, WS_XN), WSP(const bf16_t, WS_WINE), M, NE, D}; pg8::StaticOrder S; S.init(M, NE, F.G, (int)blockIdx.x);
        pg8::EpiInE E; E.na0 = A->out + O_NAP; E.nb0 = A->out + O_NBP; E.na1 = A->out + O_NAS - (size_t)MP * 1024; E.nb1 = A->out + O_NBS - (size_t)MP * 320;
        E.QA = WSP(bf16_t, WS_QA); E.KA = WSP(bf16_t, WS_KA); E.VA = WSP(bf16_t, WS_VA); E.QB = WSP(bf16_t, WS_QB); E.KB = WSP(bf16_t, WS_KB); E.VB = WSP(bf16_t, WS_VB);
        E.QI = WSP(bf16_t, WS_QI); E.KI = WSP(bf16_t, WS_KI); E.WI = WSP(float, WS_WI); E.c2 = C2Q;
        pg8::gemm_phase<pg8::EpiInE, pg8::StaticOrder, true, true>(F.lds, g, S, E);
    } SEAM(1);
    if (IN(2)) { KA A = PHASE_ARGS();
#ifndef MK_P2
#define MK_P2 7
#endif
        if (MK_P2 & 1) for (int it = F.vcu; it < 256; it += F.G) sample_idx_item(F, A, it >> 1, it & 1);
        if (MK_P2 & 2) for (int it = F.vcu; it < 512; it += F.G) sample_diff_item(F, A, it >> 2, it & 3);
        if (MK_P2 & 4) idx_scores_prompt(F, WSP(const bf16_t, WS_QI), WSP(const bf16_t, WS_KI), WSP(const float, WS_WI), WSP(float, WS_S));
    } SEAM(2);
    if (IN(3)) { KA A = PHASE_ARGS(); topk_phase(F, A); } SEAM(3);
    if (IN(4)) { KA A = PHASE_ARGS(); att_phase(F, A, (char*)lds); } SEAM(4);
    if (IN(5)) { KA A = PHASE_ARGS(); diff_combine_phase(F, A); } SEAM(5);
    if (IN(6)) { KA A = PHASE_ARGS();
        pg8::Gemm g{WSP(bf16_t, WS_MIX), WSP(const bf16_t, WS_WOUTE), M, D, D}; pg8::StaticOrder S; S.init(M, D, F.G, (int)blockIdx.x);
        pg8::EpiRes E{A->in[0], A->in[1] - (size_t)MP * D, WSP(float, WS_V), ALPHA};
        pg8::gemm_phase<pg8::EpiRes, pg8::StaticOrder, true, true>(F.lds, g, S, E);
    } SEAM(6);
    if (IN(7)) { KA A = PHASE_ARGS(); ln_phase(F, WSP(float, WS_V), A->in[20], A->in[21], WSP(float, WS_X1), WSP(bf16_t, WS_XN)); } SEAM(7);
    if (IN(8)) { KA A = PHASE_ARGS();
        pg8::Gemm g{WSP(bf16_t, WS_XN), WSP(const bf16_t, WS_W1), M, FF, D}; pg8::StaticOrder S; S.init(M, FF, F.G, (int)blockIdx.x);
        pg8::EpiRelu2 E{WSP(bf16_t, WS_H), FF};
        pg8::gemm_phase<pg8::EpiRelu2, pg8::StaticOrder, true, true>(F.lds, g, S, E);
    } SEAM(8);
    if (IN(9)) { KA A = PHASE_ARGS();
        pg8::Gemm g{WSP(bf16_t, WS_H), WSP(const bf16_t, WS_W2), M, D, FF}; pg8::StaticOrder S; S.init(M, D, F.G, (int)blockIdx.x);
        pg8::EpiRes E{WSP(float, WS_X1), WSP(float, WS_X1), WSP(float, WS_V), ALPHA};
        pg8::gemm_phase<pg8::EpiRes, pg8::StaticOrder, true, true>(F.lds, g, S, E);
    } SEAM(9);
    if (IN(10)) { KA A = PHASE_ARGS(); ln_phase(F, WSP(float, WS_V), A->in[20] + D, A->in[21] + D, WSP(float, WS_X2), WSP(bf16_t, WS_XN)); } SEAM(10);
    if (IN(11)) { KA A = PHASE_ARGS();
        pg8::Gemm g{WSP(bf16_t, WS_XN), WSP(const bf16_t, WS_WINO), M, NO, D}; pg8::StaticOrder S; S.init(M, NO, F.G, (int)blockIdx.x);
        pg8::EpiInO E{WSP(float, WS_XC), WSP(bf16_t, WS_U), WSP(float, WS_GV)};
        pg8::gemm_phase<pg8::EpiInO, pg8::StaticOrder, true, true>(F.lds, g, S, E);
    } SEAM(11);
    if (IN(12)) { KA A = PHASE_ARGS();
        for (int it = F.vcu; it < 256; it += F.G) { if (it < 128) odd_chunk_item(F, A, it); else odd_sample_item(F, A, it - 128); }
    } SEAM(12);
    if (IN(13)) { KA A = PHASE_ARGS();
        pg8::Gemm g{WSP(bf16_t, WS_MIX2), WSP(const bf16_t, WS_WOUTO), M, D, D}; pg8::StaticOrder S; S.init(M, D, F.G, (int)blockIdx.x);
        pg8::EpiRes E{WSP(float, WS_X2), WSP(float, WS_X2), WSP(float, WS_V), ALPHA};
        pg8::gemm_phase<pg8::EpiRes, pg8::StaticOrder, true, true>(F.lds, g, S, E);
    } SEAM(13);
    if (IN(14)) { KA A = PHASE_ARGS(); ln_phase(F, WSP(float, WS_V), A->in[20] + 2 * D, A->in[21] + 2 * D, WSP(float, WS_X3), WSP(bf16_t, WS_XN)); } SEAM(14);
    if (IN(15)) { KA A = PHASE_ARGS();
        pg8::Gemm g{WSP(bf16_t, WS_XN), WSP(const bf16_t, WS_W1) + (size_t)D * FF, M, FF, D}; pg8::StaticOrder S; S.init(M, FF, F.G, (int)blockIdx.x);
        pg8::EpiRelu2 E{WSP(bf16_t, WS_H), FF};
        pg8::gemm_phase<pg8::EpiRelu2, pg8::StaticOrder, true, true>(F.lds, g, S, E);
    } SEAM(15);
    if (IN(16)) { KA A = PHASE_ARGS();
        pg8::Gemm g{WSP(bf16_t, WS_H), WSP(const bf16_t, WS_W2) + (size_t)D * FF, M, D, FF}; pg8::StaticOrder S; S.init(M, D, F.G, (int)blockIdx.x);
        pg8::EpiRes E{WSP(float, WS_X3), WSP(float, WS_X3), WSP(float, WS_V), ALPHA};
        pg8::gemm_phase<pg8::EpiRes, pg8::StaticOrder, true, true>(F.lds, g, S, E);
    } SEAM(16);
    if (IN(17)) { KA A = PHASE_ARGS(); ln_phase(F, WSP(float, WS_V), A->in[20] + 3 * D, A->in[21] + 3 * D, A->out + O_Y, nullptr); }
#undef PHASE_ARGS
#undef WSP
#undef IN
#undef SEAM
}
constexpr int N_PHASES = 18;
}
#ifndef MK_PER_PHASE
#define MK_PER_PHASE 0
#endif
static int mk_setup() {
    static int grid = 0;
    if (grid == 0) {
        int dev = 0, cus = 0, per_cu = 0;
        if (hipGetDevice(&dev) != hipSuccess || hipDeviceGetAttribute(&cus, hipDeviceAttributeMultiprocessorCount, dev) != hipSuccess) { fprintf(stderr, "kernel_launch: device query failed\n"); grid = -1; return grid; }
        if (hipFuncSetAttribute((const void*)mk::mk_fwd, hipFuncAttributeMaxDynamicSharedMemorySize, mk::LDS_BYTES) != hipSuccess) { fprintf(stderr, "kernel_launch: hipFuncSetAttribute failed\n"); grid = -1; return grid; }
        if (hipOccupancyMaxActiveBlocksPerMultiprocessor(&per_cu, (const void*)mk::mk_fwd, mk::NWAVES * 64, mk::LDS_BYTES) != hipSuccess || per_cu < 1) fprintf(stderr, "kernel_launch: occupancy query says %d\n", per_cu);
        (void)hipGetLastError();
        grid = cus;
    }
    return grid;
}
static void mk_launch(void* const* d_in, void* d_out, void* d_ws, hipStream_t stream) {
    const int grid = mk_setup(); if (grid <= 0) return;
    (void)hipMemsetAsync((char*)d_ws + mk::WS_CTL, 0, mk::CTL_ZERO_BYTES, stream);
    mk::Args a{};
    for (int i = 0; i < 22; ++i) a.in[i] = (const float*)d_in[i];
    a.out = (float*)d_out; a.ws = (unsigned char*)d_ws;
#if MK_PER_PHASE
    for (int p = 0; p < mk::N_PHASES; ++p) { a.ph_lo = p; a.ph_hi = p + 1; hipLaunchKernelGGL(mk::mk_fwd, dim3(grid), dim3(mk::NWAVES * 64), mk::LDS_BYTES, stream, a); }
#else
#ifdef DBG_STOP_PHASE
    a.ph_lo = 0; a.ph_hi = DBG_STOP_PHASE;
#else
    a.ph_lo = 0; a.ph_hi = mk::N_PHASES;
#endif
    hipLaunchKernelGGL(mk::mk_fwd, dim3(grid), dim3(mk::NWAVES * 64), mk::LDS_BYTES, stream, a);
#endif
    const hipError_t le = hipPeekAtLastError();
    if (le != hipSuccess) fprintf(stderr, "kernel_launch: launch failed: %s\n", hipGetErrorName(le));
}
extern "C" void kernel_launch(void* const* d_in, const int* in_sizes, int n_in, void* d_out, int out_size, void* d_ws, size_t ws_size, hipStream_t stream) {
    if (n_in != 22 || out_size != (int)mk::O_END || ws_size < mk::WS_FAST_END) { fprintf(stderr, "kernel_launch: unexpected shapes (n_in %d out %d ws %zu)\n", n_in, out_size, ws_size); return; }
    mk_launch(d_in, d_out, d_ws, stream);
}
```
